# Optimizing an MI355X kernel written in HIP

```python
import math
import jax, jax.numpy as jnp
from jax import lax
import numpy as np

D_MODEL = 1024
BATCH = 16
SEQ = 256
DEPTH = 1
DEC_BATCH = 4
DEC_SEQ = 2048
PAST_LEN = 256

GRID_W = 64
MIX_WIDTH = D_MODEL
RET_WIDTH = MIX_WIDTH // 2
RET_HEADS = 4
RET_DK = RET_WIDTH // RET_HEADS
RET_DV = RET_DK
S5_WIDTH = MIX_WIDTH - RET_WIDTH
S5_CH = 16
S5_GROUPS = S5_WIDTH // S5_CH
S5_STATE = 64
D_FF = 4 * D_MODEL
CTX_CHUNK = 64
N_DIR = 2
ALPHA = (2 * DEPTH) ** 0.25
BETA = (8 * DEPTH) ** -0.25
LN_EPS = 1e-5
IN_COLS = 4 * RET_WIDTH + S5_WIDTH

kernel_name = "hymba_retnet_s5_prefix_dit_step"


def _norm(x):
    xf = x.astype(jnp.float32)
    mu = jnp.mean(xf, axis=-1, keepdims=True)
    var = jnp.mean(jnp.square(xf - mu), axis=-1, keepdims=True)
    return ((xf - mu) * lax.rsqrt(var + LN_EPS)).astype(x.dtype)


def _ln_affine(x, g, b):
    return (_norm(x).astype(jnp.float32) * g.astype(jnp.float32) + b.astype(jnp.float32)).astype(x.dtype)


def _retention_forward(q, k, v, log_gamma, s0, chunk, n_chunks):
    b, h, _, dk = q.shape
    dv = v.shape[-1]
    qc = q.reshape(b, h, n_chunks, chunk, dk)
    kc = k.reshape(b, h, n_chunks, chunk, dk)
    vc = v.reshape(b, h, n_chunks, chunk, dv)
    pos = jnp.arange(chunk, dtype=jnp.float32)
    lg = log_gamma[:, None]
    rel = pos[:, None] - pos[None, :]
    decay_mat = jnp.where(rel[None] >= 0, jnp.exp(lg[..., None] * jnp.maximum(rel, 0.0)[None]), 0.0)
    scores = jnp.einsum('bhnid,bhnjd->bhnij', qc, kc) * decay_mat[None, :, None]
    o_intra = jnp.einsum('bhnij,bhnje->bhnie', scores, vc)
    k_dec = kc * jnp.exp(lg * (chunk - 1 - pos))[None, :, None, :, None]
    kv = jnp.einsum('bhnjd,bhnje->nbhde', k_dec, vc)
    chunk_decay = jnp.exp(log_gamma * chunk)[None, :, None, None]

    def step(s, kv_n):
        return chunk_decay * s + kv_n, s

    s_final, s_prev = lax.scan(step, s0, kv)
    o_inter = jnp.einsum('bhnid,nbhde->bhnie', qc, s_prev) * jnp.exp(lg * (pos + 1.0))[None, :, None, :, None]
    o = (o_intra + o_inter).reshape(b, h, n_chunks * chunk, dv)
    return o, s_final


def _bidir_retention(q, k, v, log_gamma2, s0_2, chunk, n_chunks):
    flip = lambda t: jnp.flip(t, axis=2)
    o_f, s_f = _retention_forward(q, k, v, log_gamma2[0], s0_2[:, 0], chunk, n_chunks)
    o_b, s_b = _retention_forward(flip(q), flip(k), flip(v), log_gamma2[1], s0_2[:, 1], chunk, n_chunks)
    return o_f + flip(o_b), jnp.stack([s_f, s_b], axis=1)


def _lin_combine(e1, e2):
    a1, x1 = e1
    a2, x2 = e2
    return a1 * a2, a2 * x1 + x2


def _s5_scan(u_c, a_re, a_im, log_dt, b_mat, s0):
    l = u_c.shape[1]
    a = lax.complex(a_re, a_im)
    a_dt = a * jnp.exp(log_dt)[:, None]
    a_bar = jnp.exp(a_dt)
    b_bar = ((a_bar - 1.0) / a)[..., None] * b_mat
    bu = jnp.einsum('gpc,blgc->blgp', b_bar, u_c)
    a_all = jnp.broadcast_to(a_bar, bu.shape)
    _, s = lax.associative_scan(_lin_combine, (a_all, bu), axis=1)
    steps = jnp.arange(1, l + 1, dtype=jnp.float32)[:, None, None]
    s = s + jnp.exp(steps * a_dt[None])[None] * s0[:, None]
    return s, s[:, -1]


def _bidir_s5(u, a_re2, a_im2, log_dt2, b_re, b_im, c_re, c_im, d_skip, s0_re2, s0_im2):
    f32 = lambda t: t.astype(jnp.float32)
    u_c = u.astype(jnp.complex64)
    b_mat = lax.complex(f32(b_re), f32(b_im))
    c_mat = lax.complex(f32(c_re), f32(c_im))
    s0 = lax.complex(f32(s0_re2), f32(s0_im2))
    s_f, fin_f = _s5_scan(u_c, f32(a_re2[0]), f32(a_im2[0]), f32(log_dt2[0]), b_mat, s0[:, 0])
    s_b, fin_b = _s5_scan(jnp.flip(u_c, axis=1), f32(a_re2[1]), f32(a_im2[1]), f32(log_dt2[1]), b_mat, s0[:, 1])
    s = s_f + jnp.flip(s_b, axis=1)
    y = jnp.real(jnp.einsum('gcp,blgp->blgc', c_mat, s)) + f32(d_skip).reshape(S5_GROUPS, S5_CH) * u
    fin = jnp.stack([fin_f, fin_b], axis=1)
    return y, jnp.real(fin), jnp.imag(fin)


def _trunk_layer(x, cond, ret_s0, s5_s0_re, s5_s0_im, chunk, n_chunks,
                 w_ada, b_ada, w_in, ret_decay, s5_a_re, s5_a_im, s5_log_dt,
                 s5_b_re, s5_b_im, s5_c_re, s5_c_im, s5_d, w_glu, b_glu, w_out,
                 ln1_g, ln1_b, w_ff1, b_ff1, w_ff2, b_ff2, ln2_g, ln2_b):
    bsz, l, _ = x.shape
    mod = jax.nn.silu(cond) @ w_ada + b_ada
    sh1, sc1, g1, sh2, sc2, g2 = jnp.split(mod[:, None, :], 6, axis=-1)
    h = _norm(x) * (1.0 + sc1) + sh1
    proj = h @ w_in
    q, k, v, g, u = jnp.split(proj, [RET_WIDTH, 2 * RET_WIDTH, 3 * RET_WIDTH, 4 * RET_WIDTH], axis=-1)
    heads = lambda t: t.reshape(bsz, l, RET_HEADS, RET_DK).transpose(0, 2, 1, 3).astype(jnp.float32)
    o_ret, ret_state = _bidir_retention(heads(q), heads(k) * (RET_DK ** -0.5), heads(v),
                                        jax.nn.log_sigmoid(ret_decay.astype(jnp.float32)),
                                        ret_s0.astype(jnp.float32), chunk, n_chunks)
    o_ret = _norm(o_ret).transpose(0, 2, 1, 3).reshape(bsz, l, RET_WIDTH)
    o_ret = o_ret * jax.nn.silu(g.astype(jnp.float32))
    y, s5_re, s5_im = _bidir_s5(u.reshape(bsz, l, S5_GROUPS, S5_CH).astype(jnp.float32),
                                s5_a_re, s5_a_im, s5_log_dt, s5_b_re, s5_b_im, s5_c_re, s5_c_im,
                                s5_d, s5_s0_re, s5_s0_im)
    y = jax.nn.gelu(y.reshape(bsz, l, S5_WIDTH))
    y = y * jax.nn.sigmoid(y @ w_glu.astype(jnp.float32) + b_glu.astype(jnp.float32))
    mix = jnp.concatenate([o_ret, y], axis=-1).astype(x.dtype) @ w_out
    x = _ln_affine(ALPHA * x + g1 * mix, ln1_g, ln1_b)
    h = _norm(x) * (1.0 + sc2) + sh2
    f = jnp.square(jax.nn.relu(h @ w_ff1 + b_ff1)) @ w_ff2 + b_ff2
    x = _ln_affine(ALPHA * x + g2 * f, ln2_g, ln2_b)
    return x, ret_state, s5_re, s5_im


def setup_inputs(seed: int = 0) -> dict:
    key = jax.random.key(seed)
    ks = jax.random.split(key, 40)
    nrm = lambda i, shape, s: s * jax.random.normal(ks[i], shape, jnp.float32)
    ret_init = jnp.asarray(np.log(2.0 ** (5 + np.arange(RET_HEADS)) - 1.0), jnp.float32)
    a_im_init = jnp.asarray(np.pi * np.arange(S5_STATE), jnp.float32)
    inp = {}
    inp["x_prompt"] = nrm(0, (BATCH, SEQ, D_MODEL), 1.0)
    inp["x_sample"] = nrm(1, (DEC_BATCH, DEC_SEQ, D_MODEL), 1.0)
    inp["state_ret"] = nrm(2, (DEC_BATCH, DEPTH, N_DIR, RET_HEADS, RET_DK, RET_DV), 1.0)
    inp["state_s5_re"] = nrm(3, (DEC_BATCH, DEPTH, N_DIR, S5_GROUPS, S5_STATE), 0.1)
    inp["state_s5_im"] = nrm(4, (DEC_BATCH, DEPTH, N_DIR, S5_GROUPS, S5_STATE), 0.1)
    inp["c"] = nrm(5, (DEC_BATCH, D_MODEL), 1.0)
    inp["c_ctx"] = nrm(6, (D_MODEL,), 1.0)
    inp["w_ada"] = nrm(7, (DEPTH, D_MODEL, 6 * D_MODEL), 0.5 * D_MODEL ** -0.5)
    inp["b_ada"] = nrm(8, (DEPTH, 6 * D_MODEL), 0.02)
    inp["w_in"] = nrm(9, (DEPTH, D_MODEL, IN_COLS), D_MODEL ** -0.5)
    inp["ret_decay"] = ret_init + nrm(10, (DEPTH, N_DIR, RET_HEADS), 0.05)
    inp["s5_a_re"] = -0.5 + nrm(11, (DEPTH, N_DIR, S5_GROUPS, S5_STATE), 0.01)
    inp["s5_a_im"] = a_im_init + nrm(12, (DEPTH, N_DIR, S5_GROUPS, S5_STATE), 0.01)
    inp["s5_log_dt"] = jax.random.uniform(ks[13], (DEPTH, N_DIR, S5_GROUPS), jnp.float32, math.log(1e-3), math.log(1e-1))
    inp["s5_b_re"] = nrm(14, (DEPTH, S5_GROUPS, S5_STATE, S5_CH), (2.0 * S5_CH) ** -0.5)
    inp["s5_b_im"] = nrm(15, (DEPTH, S5_GROUPS, S5_STATE, S5_CH), (2.0 * S5_CH) ** -0.5)
    inp["s5_c_re"] = nrm(16, (DEPTH, S5_GROUPS, S5_CH, S5_STATE), (2.0 * S5_STATE) ** -0.5)
    inp["s5_c_im"] = nrm(17, (DEPTH, S5_GROUPS, S5_CH, S5_STATE), (2.0 * S5_STATE) ** -0.5)
    inp["s5_d"] = nrm(18, (DEPTH, S5_WIDTH), 1.0)
    inp["w_glu"] = nrm(19, (DEPTH, S5_WIDTH, S5_WIDTH), S5_WIDTH ** -0.5)
    inp["b_glu"] = nrm(20, (DEPTH, S5_WIDTH), 0.02)
    inp["w_out"] = nrm(21, (DEPTH, MIX_WIDTH, D_MODEL), BETA * MIX_WIDTH ** -0.5)
    inp["ln1_g"] = 1.0 + nrm(22, (DEPTH, D_MODEL), 0.02)
    inp["ln1_b"] = nrm(23, (DEPTH, D_MODEL), 0.02)
    inp["w_ff1"] = nrm(24, (DEPTH, D_MODEL, D_FF), D_MODEL ** -0.5)
    inp["b_ff1"] = nrm(25, (DEPTH, D_FF), 0.02)
    inp["w_ff2"] = nrm(26, (DEPTH, D_FF, D_MODEL), BETA * D_FF ** -0.5)
    inp["b_ff2"] = nrm(27, (DEPTH, D_MODEL), 0.02)
    inp["ln2_g"] = 1.0 + nrm(28, (DEPTH, D_MODEL), 0.02)
    inp["ln2_b"] = nrm(29, (DEPTH, D_MODEL), 0.02)
    return inp


def reference(x_prompt, x_sample, state_ret, state_s5_re, state_s5_im, c, c_ctx,
              w_ada, b_ada, w_in, ret_decay, s5_a_re, s5_a_im, s5_log_dt,
              s5_b_re, s5_b_im, s5_c_re, s5_c_im, s5_d, w_glu, b_glu, w_out,
              ln1_g, ln1_b, w_ff1, b_ff1, w_ff2, b_ff2, ln2_g, ln2_b):
    n_ctx_chunks = x_prompt.shape[1] // CTX_CHUNK
    rows = x_sample.shape[1] // GRID_W
    bp = x_prompt.shape[0]
    zeros_ret = jnp.zeros((bp, N_DIR, RET_HEADS, RET_DK, RET_DV), jnp.float32)
    zeros_s5 = jnp.zeros((bp, N_DIR, S5_GROUPS, S5_STATE), jnp.float32)
    y_p, y_s = x_prompt, x_sample
    rets, s5rs, s5is = [], [], []
    for layer in range(DEPTH):
        params = (w_ada[layer], b_ada[layer], w_in[layer], ret_decay[layer], s5_a_re[layer], s5_a_im[layer],
                  s5_log_dt[layer], s5_b_re[layer], s5_b_im[layer], s5_c_re[layer], s5_c_im[layer], s5_d[layer],
                  w_glu[layer], b_glu[layer], w_out[layer], ln1_g[layer], ln1_b[layer], w_ff1[layer], b_ff1[layer],
                  w_ff2[layer], b_ff2[layer], ln2_g[layer], ln2_b[layer])
        y_p, r_st, s5_re, s5_im = _trunk_layer(y_p, c_ctx[None, :], zeros_ret, zeros_s5, zeros_s5,
                                               CTX_CHUNK, n_ctx_chunks, *params)
        rets.append(r_st)
        s5rs.append(s5_re)
        s5is.append(s5_im)
        y_s, _, _, _ = _trunk_layer(y_s, c, state_ret[:, layer], state_s5_re[:, layer], state_s5_im[:, layer],
                                    GRID_W, rows, *params)
    new_state_ret = jnp.stack(rets, axis=1)
    new_state_s5_re = jnp.stack(s5rs, axis=1)
    new_state_s5_im = jnp.stack(s5is, axis=1)
    return (y_p, y_s, new_state_ret, new_state_s5_re, new_state_s5_im)
```

```cpp
#include <hip/hip_runtime.h>
#include <cstdio>
#include <cstdint>
namespace pg8 {
#define PG8_LAS __attribute__((address_space(3)))
typedef unsigned short bf16_t;
typedef short bf16x8 __attribute__((ext_vector_type(8)));
typedef float f32x4 __attribute__((ext_vector_type(4)));
typedef unsigned u32x4 __attribute__((ext_vector_type(4)));
constexpr int BM = 256, BK = 64, HALF = 128, HTB = HALF * BK * 2  , STAGE_BYTES = 8 * HTB, NXCD = 8, WGM = 8;

__host__ __device__ __forceinline__ int lds_byte(int r, int c) { const int st = (r >> 4) * 2 + (c >> 5), rr = r & 15, cc = c & 31, ob = rr * 64 + cc * 2; return st * 1024 + (ob ^ (((ob >> 9) & 1) << 5)); }
__host__ __device__ __forceinline__ void stage_rc(int b, int& R, int& C) { const int st = b / 1024, sb = b % 1024, swz = sb ^ (((sb >> 9) & 1) << 5); R = (st >> 1) * 16 + swz / 64; C = (st & 1) * 32 + (swz % 64) / 2; }
__host__ __device__ __forceinline__ int perm32(int rho) { const int n = rho >> 4, i = rho & 15; return 8 * (i >> 2) + 4 * n + (i & 3); }

struct Unit { int pm, pn; };
struct Gemm { const bf16_t* A; const bf16_t* Bt; int M, N, K; };

struct StaticOrder {
    int nM, nN, nwg, G, c;
    __host__ __device__ void init(int M, int N, int G_, int c_) { nM = M / BM; nN = N / BM; nwg = nM * nN; G = G_; c = c_; }
    __host__ __device__ bool next(int i, Unit& u) const {
        const long L = (long)i * G + c; if (L >= nwg) return false;
        int wgid = (int)L; { const int q = nwg / NXCD, r = nwg % NXCD, xcd = wgid % NXCD, off = wgid / NXCD; wgid = (xcd < r ? xcd * (q + 1) : r * (q + 1) + (xcd - r) * q) + off; }
        const int nig = WGM * nN, gid = wgid / nig, fm = gid * WGM, gsz = (nM - fm) < WGM ? (nM - fm) : WGM;
        u.pm = fm + ((wgid % nig) % gsz); u.pn = (wgid % nig) / gsz; return true;
    }
    __device__ __forceinline__ void a_ready(const Unit&) const {}
    __device__ __forceinline__ void done(const Unit&) const {}
};

__device__ __forceinline__ unsigned cvt_pk_bf16(float lo, float hi) { unsigned r; asm volatile("v_cvt_pk_bf16_f32 %0, %1, %2" : "=v"(r) : "v"(lo), "v"(hi)); return r; }
typedef float f32x2 __attribute__((ext_vector_type(2)));
__device__ __forceinline__ f32x2 gelu_pk(f32x2 v) {
    const f32x2 av = __builtin_elementwise_abs(v), d = av * 0.2316418882f + 1.0f;
    f32x2 t; t.x = __builtin_amdgcn_rcpf(d.x); t.y = __builtin_amdgcn_rcpf(d.y);
    f32x2 q = t * 0.5307027145f + (-0.7265760135f); q = q * t + 0.7107068705f; q = q * t + (-0.142248368f); q = q * t + 0.127414796f; q = q * t;
    const f32x2 s = (v * v) * (-0.72134752044f);
    f32x2 e; e.x = __builtin_amdgcn_exp2f(s.x); e.y = __builtin_amdgcn_exp2f(s.y);
    const f32x2 m = v * (q * e), r = v - m;
    f32x2 o; o.x = v.x < 0.f ? m.x : r.x; o.y = v.y < 0.f ? m.y : r.y; return o;
}

template <int ACT  > struct EpiBf16 {
    static constexpr bool PERM = true, AFTER_DRAIN = false; static_assert(ACT == 0 || ACT == 1, "EpiBf16: ACT is 0 (none) or 1 (gelu_pk)");
    bf16_t* O; int ldc; const float* bias; int split_cols; size_t split_stride; float scale0;
    __device__ __forceinline__ void operator()(const f32x4 (&acc)[2][2][4][2], const Unit& u, int wr, int wc, int fr, int fq) const {
        const int row0 = u.pm * BM + wr * 64 + fr; int colt = u.pn * BM; bf16_t* base = O;
        float sc = 1.f; if (split_cols) { const int t = colt / split_cols; base += (size_t)t * split_stride; colt -= t * split_cols; if (t == 0) sc = scale0; }
        const int col0 = colt + wc * 32 + 8 * fq, bcol0 = u.pn * BM + wc * 32 + 8 * fq;
        f32x4 bv[2][2];
#pragma unroll
        for (int bj = 0; bj < 2; ++bj)
#pragma unroll
            for (int n = 0; n < 2; ++n) bv[bj][n] = bias ? *(const f32x4*)(bias + bcol0 + bj * HALF + 4 * n) : (f32x4){0.f, 0.f, 0.f, 0.f};
#pragma unroll
        for (int ai = 0; ai < 2; ++ai)
#pragma unroll
            for (int m = 0; m < 4; ++m) { bf16_t* rowp = base + (size_t)(row0 + ai * HALF + m * 16) * ldc + col0;
#pragma unroll
                for (int bj = 0; bj < 2; ++bj) { f32x4 v0 = acc[ai][bj][m][0] + bv[bj][0], v1 = acc[ai][bj][m][1] + bv[bj][1];
                    if (ACT == 1) { f32x2 a = gelu_pk((f32x2){v0[0], v0[1]}), b = gelu_pk((f32x2){v0[2], v0[3]}), c = gelu_pk((f32x2){v1[0], v1[1]}), d = gelu_pk((f32x2){v1[2], v1[3]});
                        v0 = (f32x4){a.x, a.y, b.x, b.y}; v1 = (f32x4){c.x, c.y, d.x, d.y}; }
                    v0 = v0 * sc; v1 = v1 * sc; u32x4 w; w.x = cvt_pk_bf16(v0[0], v0[1]); w.y = cvt_pk_bf16(v0[2], v0[3]); w.z = cvt_pk_bf16(v1[0], v1[1]); w.w = cvt_pk_bf16(v1[2], v1[3]);
                    *(u32x4*)(rowp + bj * HALF) = w; } }
    }
};
struct EpiSqRelu {
    static constexpr bool PERM = true, AFTER_DRAIN = false;
    bf16_t* O; int ldc; const float* bias;
    __device__ __forceinline__ void operator()(const f32x4 (&acc)[2][2][4][2], const Unit& u, int wr, int wc, int fr, int fq) const {
        const int row0 = u.pm * BM + wr * 64 + fr; const int col0 = u.pn * BM + wc * 32 + 8 * fq;
        f32x4 bv[2][2];
#pragma unroll
        for (int bj = 0; bj < 2; ++bj)
#pragma unroll
            for (int n = 0; n < 2; ++n) bv[bj][n] = *(const f32x4*)(bias + col0 + bj * HALF + 4 * n);
#pragma unroll
        for (int ai = 0; ai < 2; ++ai)
#pragma unroll
            for (int m = 0; m < 4; ++m) { bf16_t* rowp = O + (size_t)(row0 + ai * HALF + m * 16) * ldc + col0;
#pragma unroll
                for (int bj = 0; bj < 2; ++bj) { f32x4 v0 = acc[ai][bj][m][0] + bv[bj][0], v1 = acc[ai][bj][m][1] + bv[bj][1];
#pragma unroll
                    for (int e = 0; e < 4; ++e) { const float a = fmaxf(v0[e], 0.f), b = fmaxf(v1[e], 0.f); v0[e] = a * a; v1[e] = b * b; }
                    u32x4 w; w.x = cvt_pk_bf16(v0[0], v0[1]); w.y = cvt_pk_bf16(v0[2], v0[3]); w.z = cvt_pk_bf16(v1[0], v1[1]); w.w = cvt_pk_bf16(v1[2], v1[3]);
                    *(u32x4*)(rowp + bj * HALF) = w; } }
    }
};
struct EpiGlu {
    static constexpr bool PERM = true, AFTER_DRAIN = false;
    const bf16_t* Y; int ldy; bf16_t* O; int ldo; int ocol0; const float* bias;
    __device__ __forceinline__ void operator()(const f32x4 (&acc)[2][2][4][2], const Unit& u, int wr, int wc, int fr, int fq) const {
        const int row0 = u.pm * BM + wr * 64 + fr; const int col0 = u.pn * BM + wc * 32 + 8 * fq;
        f32x4 bv[2][2];
#pragma unroll
        for (int bj = 0; bj < 2; ++bj)
#pragma unroll
            for (int n = 0; n < 2; ++n) bv[bj][n] = *(const f32x4*)(bias + col0 + bj * HALF + 4 * n);
#pragma unroll
        for (int ai = 0; ai < 2; ++ai)
#pragma unroll
            for (int m = 0; m < 4; ++m) { const size_t row = (size_t)(row0 + ai * HALF + m * 16);
#pragma unroll
                for (int bj = 0; bj < 2; ++bj) { const f32x4 v0 = acc[ai][bj][m][0] + bv[bj][0], v1 = acc[ai][bj][m][1] + bv[bj][1];
                    const u32x4 yv = *(const u32x4*)(Y + row * ldy + col0 + bj * HALF);
                    float y[8]; y[0] = __uint_as_float(yv.x << 16); y[1] = __uint_as_float(yv.x & 0xffff0000u); y[2] = __uint_as_float(yv.y << 16); y[3] = __uint_as_float(yv.y & 0xffff0000u);
                    y[4] = __uint_as_float(yv.z << 16); y[5] = __uint_as_float(yv.z & 0xffff0000u); y[6] = __uint_as_float(yv.w << 16); y[7] = __uint_as_float(yv.w & 0xffff0000u);
                    float o[8];
#pragma unroll
                    for (int e = 0; e < 4; ++e) { o[e] = y[e] / (1.f + __expf(-v0[e])); o[4 + e] = y[4 + e] / (1.f + __expf(-v1[e])); }
                    u32x4 w; w.x = cvt_pk_bf16(o[0], o[1]); w.y = cvt_pk_bf16(o[2], o[3]); w.z = cvt_pk_bf16(o[4], o[5]); w.w = cvt_pk_bf16(o[6], o[7]);
                    *(u32x4*)(O + row * ldo + ocol0 + col0 + bj * HALF) = w; } }
    }
};
struct EpiRes {
    static constexpr bool PERM = false, AFTER_DRAIN = false;
    const float* xlo; const float* xhi; float* Z; const float* bias; const float* mod; int goff; float alpha;
    __device__ __forceinline__ void operator()(const f32x4 (&acc)[2][2][4][2], const Unit& u, int wr, int wc, int fr, int fq) const {
        const int row0 = u.pm * BM + wr * 64 + fr, col0 = u.pn * BM + wc * 32 + 4 * fq;
        const int ci = u.pm < 16 ? 0 : 1 + ((u.pm - 16) >> 3);
        const float* gp = mod + ci * 6144 + goff;
        f32x4 bv[2][2], gv[2][2];
#pragma unroll
        for (int bj = 0; bj < 2; ++bj)
#pragma unroll
            for (int n = 0; n < 2; ++n) { bv[bj][n] = bias ? *(const f32x4*)(bias + col0 + bj * HALF + n * 16) : (f32x4){0.f, 0.f, 0.f, 0.f}; gv[bj][n] = *(const f32x4*)(gp + col0 + bj * HALF + n * 16); }
#pragma unroll
        for (int ai = 0; ai < 2; ++ai)
#pragma unroll
            for (int m = 0; m < 4; ++m) { const int row = row0 + ai * HALF + m * 16;
                const float* xr = (row < 4096 ? xlo + (size_t)row * 1024 : xhi + (size_t)(row - 4096) * 1024) + col0; float* zr = Z + (size_t)row * 1024 + col0;
#pragma unroll
                for (int bj = 0; bj < 2; ++bj)
#pragma unroll
                    for (int n = 0; n < 2; ++n) { const f32x4 xv = *(const f32x4*)(xr + bj * HALF + n * 16);
                        *(f32x4*)(zr + bj * HALF + n * 16) = xv * alpha + gv[bj][n] * (acc[ai][bj][m][n] + bv[bj][n]); } }
    }
};
template <class Epi, class Sched, bool ALIGN_EPI = false, bool SP2 = false>
__device__ __forceinline__ void gemm_phase(PG8_LAS unsigned char* lds, const Gemm g, const Sched& S, const Epi& E) {
    const int tid = threadIdx.x, wid = __builtin_amdgcn_readfirstlane(tid >> 6), lane = tid & 63, wr = wid >> 2, wc = wid & 3, fr = lane & 15, fq = lane >> 4;
    const int K = g.K, nt = K / BK;
    unsigned voffA[2], voffB[2];
#pragma unroll
    for (int i = 0; i < 2; ++i) { int R, C; stage_rc(tid * 16 + i * 8192, R, C); const int Rb = Epi::PERM ? ((R & ~31) + perm32(R & 31)) : R;
        voffA[i] = (unsigned)(R * K + C) * 2u; voffB[i] = (unsigned)(Rb * K + C) * 2u; }
    const size_t kstep = (size_t)(BK * 2);
    const size_t hstep = (size_t)HALF * K * 2;
    const size_t tstep = 2 * hstep;
    const unsigned ldsw = (unsigned)wid * 1024u;
    const int aoff = lds_byte(wr * 64 + fr, fq * 8), boff = lds_byte(wc * 32 + fr, fq * 8);
#define PG8_SA(b, h) (((b) * 2 + (h)) * HTB)
#define PG8_SB(b, h) ((4 + (b) * 2 + (h)) * HTB)
#define PG8_STAGE(bufoff, gbase, voff) do { _Pragma("unroll") for (int _i = 0; _i < 2; ++_i) \
        __builtin_amdgcn_global_load_lds((const unsigned*)((const char*)(gbase) + (voff)[_i]), (PG8_LAS unsigned*)(lds + (bufoff) + ldsw + _i * 8192), 16, 0, 0); } while (0)
#define PG8_LDA(dst, b, h) do { _Pragma("unroll") for (int m = 0; m < 4; ++m) _Pragma("unroll") for (int k = 0; k < 2; ++k) dst[m][k] = *(const PG8_LAS bf16x8*)(lds + PG8_SA(b, h) + aoff + m * 2048 + k * 1024); } while (0)
#define PG8_LDB(dst, b, h) do { _Pragma("unroll") for (int n = 0; n < 2; ++n) _Pragma("unroll") for (int k = 0; k < 2; ++k) dst[n][k] = *(const PG8_LAS bf16x8*)(lds + PG8_SB(b, h) + boff + n * 2048 + k * 1024); } while (0)
#define PG8_MMA(ai, bj, At, Bt) do { __builtin_amdgcn_s_setprio(1); _Pragma("unroll") for (int m = 0; m < 4; ++m) _Pragma("unroll") for (int n = 0; n < 2; ++n) _Pragma("unroll") for (int k = 0; k < 2; ++k) \
        acc[ai][bj][m][n] = __builtin_amdgcn_mfma_f32_16x16x32_bf16(Bt[n][k], At[m][k], acc[ai][bj][m][n], 0, 0, 0); __builtin_amdgcn_s_setprio(0); } while (0)
#define PG8_WAIT_V(n) asm volatile("s_waitcnt vmcnt(" #n ")" ::: "memory")
#define PG8_WAIT_L(n) asm volatile("s_waitcnt lgkmcnt(" #n ")" ::: "memory")
#define PG8_BAR __builtin_amdgcn_s_barrier()
#define PG8_SCHED __builtin_amdgcn_sched_barrier(0)
    Unit cur, nxt; int ui = 0;
    if (!S.next(0, cur)) return;
    f32x4 acc[2][2][4][2];
#pragma unroll
    for (int a = 0; a < 2; ++a)
#pragma unroll
        for (int b = 0; b < 2; ++b)
#pragma unroll
            for (int m = 0; m < 4; ++m)
#pragma unroll
                for (int n = 0; n < 2; ++n) acc[a][b][m][n] = (f32x4){0.f, 0.f, 0.f, 0.f};
    bf16x8 At[4][2], B0[2][2], B1[2][2];
    const char* cA = (const char*)g.A + (size_t)cur.pm * tstep; const char* cB = (const char*)g.Bt + (size_t)cur.pn * tstep;
    S.a_ready(cur);
    if constexpr (SP2) {
        PG8_STAGE(PG8_SB(0, 0), cB, voffB); PG8_STAGE(PG8_SB(0, 1), cB + hstep, voffB); PG8_STAGE(PG8_SA(0, 0), cA, voffA); PG8_STAGE(PG8_SA(0, 1), cA + hstep, voffA);
        if (wr == 1) PG8_BAR;
        PG8_WAIT_V(2); PG8_BAR;
        PG8_STAGE(PG8_SB(1, 0), cB + kstep, voffB); PG8_STAGE(PG8_SA(1, 0), cA + kstep, voffA); PG8_STAGE(PG8_SB(1, 1), cB + hstep + kstep, voffB);
        PG8_WAIT_V(6); PG8_BAR;
    } else {
        PG8_STAGE(PG8_SB(0, 0), cB, voffB); PG8_STAGE(PG8_SA(0, 0), cA, voffA); PG8_STAGE(PG8_SB(0, 1), cB + hstep, voffB); PG8_STAGE(PG8_SA(0, 1), cA + hstep, voffA);
        if (wr == 1) PG8_BAR;
        PG8_WAIT_V(4); PG8_BAR;
        PG8_STAGE(PG8_SB(1, 0), cB + kstep, voffB); PG8_STAGE(PG8_SA(1, 0), cA + kstep, voffA); PG8_STAGE(PG8_SB(1, 1), cB + hstep + kstep, voffB);
        PG8_WAIT_V(6); PG8_BAR;
    }
    for (;;) {
        const bool has_next = S.next(ui + 1, nxt);
        const char* nA = has_next ? (const char*)g.A + (size_t)nxt.pm * tstep : cA; const char* nB = has_next ? (const char*)g.Bt + (size_t)nxt.pn * tstep : cB;
        for (int t = 0; t < nt; t += 2) {
            const bool last = (t == nt - 2);
            const char* a1 = cA + (size_t)(t + 1) * kstep;
            const char* a2 = last ? nA : cA + (size_t)(t + 2) * kstep; const char* b2 = last ? nB : cB + (size_t)(t + 2) * kstep;
            const char* a3 = a2 + kstep; const char* b3 = b2 + kstep;
            if (last && has_next) S.a_ready(nxt);
            if constexpr (SP2) {
            PG8_LDB(B0, 0, 0); PG8_LDB(B1, 0, 1); PG8_SCHED; PG8_LDA(At, 0, 0); PG8_STAGE(PG8_SA(1, 1), a1 + hstep, voffA);
            PG8_WAIT_V(8); PG8_WAIT_L(0); PG8_BAR; PG8_MMA(0, 0, At, B0); PG8_MMA(0, 1, At, B1); PG8_BAR; PG8_SCHED;
            PG8_LDA(At, 0, 1); PG8_STAGE(PG8_SB(0, 0), b2, voffB); PG8_STAGE(PG8_SB(0, 1), b2 + hstep, voffB); PG8_STAGE(PG8_SA(0, 0), a2, voffA);
            PG8_WAIT_V(8); PG8_WAIT_L(0); PG8_BAR; PG8_MMA(1, 0, At, B0); PG8_MMA(1, 1, At, B1); PG8_BAR; PG8_SCHED;
            PG8_LDB(B0, 1, 0); PG8_LDB(B1, 1, 1); PG8_SCHED; PG8_LDA(At, 1, 0); PG8_STAGE(PG8_SA(0, 1), a2 + hstep, voffA);
            PG8_WAIT_V(8); PG8_WAIT_L(0); PG8_BAR; PG8_MMA(0, 0, At, B0); PG8_MMA(0, 1, At, B1); PG8_BAR; PG8_SCHED;
            PG8_LDA(At, 1, 1); PG8_STAGE(PG8_SB(1, 0), b3, voffB); PG8_STAGE(PG8_SB(1, 1), b3 + hstep, voffB); PG8_STAGE(PG8_SA(1, 0), a3, voffA);
            PG8_WAIT_V(8); PG8_WAIT_L(0); PG8_BAR; PG8_MMA(1, 0, At, B0); PG8_MMA(1, 1, At, B1); PG8_BAR; PG8_SCHED;
            } else {
            PG8_LDB(B0, 0, 0); PG8_SCHED; PG8_LDA(At, 0, 0); PG8_STAGE(PG8_SA(1, 1), a1 + hstep, voffA);
            PG8_WAIT_L(8); PG8_BAR; PG8_WAIT_L(0); PG8_MMA(0, 0, At, B0); PG8_BAR; PG8_SCHED;
            PG8_LDB(B1, 0, 1); PG8_STAGE(PG8_SB(0, 0), b2, voffB);
            PG8_BAR; PG8_WAIT_L(0); PG8_MMA(0, 1, At, B1); PG8_BAR;
            PG8_LDA(At, 0, 1); PG8_STAGE(PG8_SA(0, 0), a2, voffA);
            PG8_BAR; PG8_WAIT_L(0); PG8_MMA(1, 0, At, B0); PG8_BAR; PG8_SCHED;
            PG8_STAGE(PG8_SB(0, 1), b2 + hstep, voffB);
            PG8_WAIT_V(6); PG8_BAR; PG8_MMA(1, 1, At, B1); PG8_BAR;
            PG8_LDB(B0, 1, 0); PG8_SCHED; PG8_LDA(At, 1, 0); PG8_STAGE(PG8_SA(0, 1), a2 + hstep, voffA);
            PG8_WAIT_L(8); PG8_BAR; PG8_WAIT_L(0); PG8_MMA(0, 0, At, B0); PG8_BAR; PG8_SCHED;
            PG8_LDB(B1, 1, 1); PG8_STAGE(PG8_SB(1, 0), b3, voffB);
            PG8_BAR; PG8_WAIT_L(0); PG8_MMA(0, 1, At, B1); PG8_BAR;
            PG8_LDA(At, 1, 1); PG8_STAGE(PG8_SA(1, 0), a3, voffA);
            PG8_BAR; PG8_WAIT_L(0); PG8_MMA(1, 0, At, B0); PG8_BAR; PG8_SCHED;
            PG8_STAGE(PG8_SB(1, 1), b3 + hstep, voffB);
            PG8_WAIT_V(6); PG8_BAR; PG8_MMA(1, 1, At, B1); PG8_BAR;
            }
        }
        if constexpr (ALIGN_EPI) { if (wr == 0) PG8_BAR; }
        if constexpr (!Epi::AFTER_DRAIN) { E(acc, cur, wr, wc, fr, fq); S.done(cur); }
        if (!has_next) break;
#pragma unroll
        for (int a = 0; a < 2; ++a)
#pragma unroll
            for (int b = 0; b < 2; ++b)
#pragma unroll
                for (int m = 0; m < 4; ++m)
#pragma unroll
                    for (int n = 0; n < 2; ++n) acc[a][b][m][n] = (f32x4){0.f, 0.f, 0.f, 0.f};
        cur = nxt; cA = nA; cB = nB; ++ui;
        if constexpr (ALIGN_EPI) { if (wr == 1) PG8_BAR; }
    }
    PG8_WAIT_V(0);
    if constexpr (!ALIGN_EPI) { if (wr == 0) PG8_BAR; }
    PG8_BAR;
    if constexpr (Epi::AFTER_DRAIN) { E.fused(acc, cur, wr, wc, fr, fq, lds, wid, lane); S.done(cur); }
#undef PG8_SA
#undef PG8_SB
#undef PG8_STAGE
#undef PG8_LDA
#undef PG8_LDB
#undef PG8_MMA
#undef PG8_WAIT_V
#undef PG8_WAIT_L
#undef PG8_BAR
#undef PG8_SCHED
}
}
#ifndef PG8_SP2
#define PG8_SP2 true
#endif
#ifndef PG8_ALIGN
#define PG8_ALIGN true
#endif
constexpr int NWAVES = 8;
constexpr int D = 1024, NTOK = 12288, NCTX = 4096, INC = 2560, FF = 4096, SW = 512;
constexpr int N_RET_UNITS = 192;
constexpr int N_S5_TASKS = 192 * 32;
constexpr float LN_EPS = 1e-5f;
constexpr float ALPHA = 1.18920711500272f;
constexpr float KSCALE = 0.08838834764831845f;
constexpr float LOG2E = 1.4426950408889634f;

constexpr size_t MiB = 1u << 20;
constexpr size_t WS_CTL = 0, CTL_ZERO_BYTES = 64 * 1024;
constexpr size_t WS_MOD = 1 * MiB;
constexpr size_t WS_ABAR = 2 * MiB, WS_AT = WS_ABAR + 64 * 1024, WS_BTAB = WS_ABAR + 128 * 1024, WS_CTAB = WS_ABAR + 512 * 1024;
constexpr size_t WS_WIN = 4 * MiB, WS_WGLU = 9 * MiB, WS_WOUT = 10 * MiB, WS_WFF1 = 12 * MiB, WS_WFF2 = 20 * MiB;
constexpr size_t WS_H = 28 * MiB;
constexpr size_t WS_X1 = 52 * MiB;
constexpr size_t WS_PROJ = 100 * MiB;
constexpr size_t WS_KV = 160 * MiB;
constexpr size_t WS_E = 176 * MiB;
constexpr size_t WS_MIX = 184 * MiB;
constexpr size_t WS_YG = 208 * MiB;
constexpr size_t WS_FFH = 100 * MiB;
constexpr size_t WS_END = 220 * MiB;
constexpr int CW_BAR = 4096;

constexpr int RING_BYTES = 131072, LDSCTL_OFF = RING_BYTES, MISC_OFF = LDSCTL_OFF + 320, LDS_BYTES = 147456;

#define GAS __attribute__((address_space(1)))
#define LAS __attribute__((address_space(3)))
typedef unsigned short bf16;
typedef unsigned v4u __attribute__((ext_vector_type(4)));
typedef float f32x4 __attribute__((ext_vector_type(4)));
typedef float f32x2 __attribute__((ext_vector_type(2)));
typedef short bf16x8 __attribute__((ext_vector_type(8)));
#define LDS_WAIT() asm volatile("s_waitcnt lgkmcnt(0)" ::: "memory")
__device__ __forceinline__ unsigned f2bf(float f) { unsigned u = __builtin_bit_cast(unsigned, f); return (u + 0x7fffu + ((u >> 16) & 1u)) >> 16; }
__device__ __forceinline__ unsigned pk2(float lo, float hi) { return f2bf(lo) | (f2bf(hi) << 16); }
__device__ __forceinline__ float bf2f(unsigned short b) { return __uint_as_float((unsigned)b << 16); }
__device__ __forceinline__ float bflo(unsigned w) { return __uint_as_float(w << 16); }
__device__ __forceinline__ float bfhi(unsigned w) { return __uint_as_float(w & 0xffff0000u); }

#define XB_TMO      128
#define XB_XCNT(j)  (256  + 64 * (j))
#define XB_XSUB(j)  (1280 + 64 * (j))
#define XB_XGEN(j)  (2304 + 64 * (j))
#define XB_TOP      3328
#define XB_TOPGEN   3392
#define XCD_BAR_WORDS 3456
#define XB_SPIN_CAP (1u << 18)
__device__ __forceinline__ unsigned xb_ld(unsigned* p)              { return __hip_atomic_load(p, __ATOMIC_RELAXED, __HIP_MEMORY_SCOPE_AGENT); }
__device__ __forceinline__ unsigned xb_add(unsigned* p, unsigned v) { return __hip_atomic_fetch_add(p, v, __ATOMIC_RELAXED, __HIP_MEMORY_SCOPE_AGENT); }
__device__ __forceinline__ unsigned xb_xcc_id() { return (unsigned)__builtin_amdgcn_s_getreg((3 << 11) | 20) & 0xFu; }
#define XB_SPIN(cond, bar) do { unsigned _sp = 0; while (cond) { __builtin_amdgcn_s_sleep(1); \
    if ((++_sp & 255u) == 0u) { if (xb_ld(&(bar)[XB_TMO])) break; if (_sp > XB_SPIN_CAP) { atomicAdd(&(bar)[XB_TMO], 1u); break; } } } } while (0)
struct XcdBarrier { unsigned* bar; unsigned x; volatile LAS unsigned* st; };
__device__ __forceinline__ XcdBarrier xcd_barrier_post(unsigned* bar, volatile LAS unsigned* st) {
    XcdBarrier b; b.bar = bar; b.x = xb_xcc_id(); b.st = st;
    if (threadIdx.x == 0) (void)xb_add(&bar[XB_XCNT(b.x)], 1u);
    return b;
}
__device__ __forceinline__ void xcd_barrier_complete(unsigned* bar, unsigned x, unsigned& nloc, unsigned& nx) {
    const unsigned G = gridDim.x * gridDim.y * gridDim.z;
    unsigned sum, cnt, mine, sp = 0u;
    for (;;) {
        sum = 0u; cnt = 0u; mine = 0u;
#pragma unroll
        for (unsigned j = 0; j < 16; ++j) { const unsigned c = xb_ld(&bar[XB_XCNT(j)]); sum += c; cnt += (c > 0u) ? 1u : 0u; mine = (j == x) ? c : mine; }
        if (sum == G) break;
        __builtin_amdgcn_s_sleep(1);
        if ((++sp & 255u) == 0u) { if (xb_ld(&bar[XB_TMO])) break; if (sp > XB_SPIN_CAP) { atomicAdd(&bar[XB_TMO], 1u); break; } }
    }
    nloc = mine > 0u ? mine : 1u; nx = cnt > 0u ? cnt : 1u;
}
__device__ __forceinline__ void xcd_barrier(const XcdBarrier& b) {
    asm volatile("s_waitcnt vmcnt(0)" ::: "memory");
    __syncthreads();
    if (threadIdx.x == 0) {
        unsigned* bar = b.bar;
        __builtin_amdgcn_s_waitcnt(0);
        unsigned nloc = b.st[0], nx = b.st[1];
        if (nloc == 0u) { xcd_barrier_complete(bar, b.x, nloc, nx); b.st[0] = nloc; b.st[1] = nx; }
        const unsigned old = xb_add(&bar[XB_XSUB(b.x)], 1u);
        const unsigned gen = old / nloc;
        if (old + 1u == (gen + 1u) * nloc) {
            __builtin_amdgcn_fence(__ATOMIC_RELEASE, "agent");
            asm volatile("s_waitcnt vmcnt(0)" ::: "memory");
            const unsigned og = xb_add(&bar[XB_TOP], 1u);
            const unsigned tg = og / nx;
            if (og + 1u == (tg + 1u) * nx) xb_add(&bar[XB_TOPGEN], 1u);
            else XB_SPIN(xb_ld(&bar[XB_TOPGEN]) == tg, bar);
            __builtin_amdgcn_fence(__ATOMIC_ACQUIRE, "agent");
            xb_add(&bar[XB_XGEN(b.x)], 1u);
            asm volatile("s_waitcnt vmcnt(0)" ::: "memory");
        } else {
            XB_SPIN(xb_ld(&bar[XB_XGEN(b.x)]) == gen, bar);
            __builtin_amdgcn_fence(__ATOMIC_ACQUIRE, "agent");
            asm volatile("s_waitcnt vmcnt(0)" ::: "memory");
        }
    }
    __syncthreads();
}

__device__ __forceinline__ float wave_sum(float v) {
#pragma unroll
    for (int o = 1; o < 64; o <<= 1) v += __shfl_xor(v, o);
    return v;
}
__device__ __forceinline__ float sum16(float v) {
    v += __shfl_xor(v, 1); v += __shfl_xor(v, 2); v += __shfl_xor(v, 4); v += __shfl_xor(v, 8); return v;
}
__device__ __forceinline__ float siluf(float v) { return v / (1.f + __expf(-v)); }
__device__ __forceinline__ float gelu_tanh(float x) {
    const float z = 0.7978845608028654f * (x + 0.044715f * x * x * x);
    const float t = 1.f - 2.f / (__expf(2.f * z) + 1.f);
    return 0.5f * x * (1.f + t);
}
__device__ __forceinline__ float log2_sigmoid(float x) { return -log1pf(expf(-x)) * LOG2E; }
__device__ __forceinline__ bf16x8 zero8() { return (bf16x8){0, 0, 0, 0, 0, 0, 0, 0}; }

__device__ __forceinline__ void p0_transpose_item(const float* W, int K, int N, bf16* WT, LAS float* scr, int item, int lane, int s0, int s1, float s) {
    const int nblk = N / 32, kb = item / nblk, nb = item % nblk, k0 = 64 * kb, n0 = 32 * nb;
    const float mul = (n0 >= s0 && n0 < s1) ? s : 1.f;
#pragma unroll 8
    for (int i = 0; i < 32; ++i) { const int kk = 2 * i + (lane >> 5); scr[kk * 33 + (lane & 31)] = W[(size_t)(k0 + kk) * N + n0 + (lane & 31)] * mul; }
    LDS_WAIT(); asm volatile("" ::: "memory");
    const int c = lane & 7;
#pragma unroll
    for (int j = 0; j < 4; ++j) { const int n = (lane >> 3) + 8 * j; const LAS float* sp = scr + (8 * c) * 33 + n;
        v4u o; o.x = pk2(sp[0 * 33], sp[1 * 33]); o.y = pk2(sp[2 * 33], sp[3 * 33]); o.z = pk2(sp[4 * 33], sp[5 * 33]); o.w = pk2(sp[6 * 33], sp[7 * 33]);
        *(GAS v4u*)(WT + (size_t)(n0 + n) * K + k0 + 8 * c) = o; }
    LDS_WAIT(); asm volatile("" ::: "memory");
}
__device__ __forceinline__ void p0_mod_item(LAS unsigned char* lds, int item, int tid, const float* c_ctx, const float* c, const float* w_ada, const float* b_ada, float* mod) {
    LAS float* sc = (LAS float*)lds; LAS float* red = (LAS float*)(lds + 20480);
    for (int i = tid; i < 5 * 1024; i += 512) { const int ci = i >> 10, k = i & 1023; const float v = (ci == 0) ? c_ctx[k] : c[(ci - 1) * 1024 + k]; sc[i] = siluf(v); }
    __syncthreads();
    const int col = tid & 31, kg = tid >> 5, n0 = item * 32;
    float acc[5] = {0.f, 0.f, 0.f, 0.f, 0.f};
#pragma unroll 16
    for (int kk = 0; kk < 64; ++kk) { const int k = kg * 64 + kk; const float w = w_ada[(size_t)k * 6144 + n0 + col];
#pragma unroll
        for (int ci = 0; ci < 5; ++ci) acc[ci] += sc[ci * 1024 + k] * w; }
#pragma unroll
    for (int ci = 0; ci < 5; ++ci) red[(kg * 5 + ci) * 32 + col] = acc[ci];
    __syncthreads();
    if (tid < 160) { const int ci = tid >> 5, c2 = tid & 31; float s = b_ada[n0 + c2];
#pragma unroll
        for (int g = 0; g < 16; ++g) s += red[(g * 5 + ci) * 32 + c2];
        mod[ci * 6144 + n0 + c2] = s; }
    __syncthreads();
}
__device__ __forceinline__ void p0_tab_item(int idx, const float* a_re, const float* a_im, const float* log_dt, const float* b_re, const float* b_im, f32x2* abar, f32x2* at, bf16* btab) {
    const int dir = idx >> 11, g = (idx >> 6) & 31, p = idx & 63;
    const double are = (double)a_re[idx], aim = (double)a_im[idx], dt = exp((double)log_dt[dir * 32 + g]);
    const double x = are * dt, y = aim * dt;
    const double ex = exp(x), br = ex * cos(y), bi = ex * sin(y);
    const double e64 = exp(64.0 * x);
    abar[idx] = (f32x2){(float)br, (float)bi};
    at[idx] = (f32x2){(float)(e64 * cos(64.0 * y)), (float)(e64 * sin(64.0 * y))};
    const double nr = br - 1.0, ni = bi, den = are * are + aim * aim;
    const float cr = (float)((nr * are + ni * aim) / den), cim = (float)((ni * are - nr * aim) / den);
    const float* pre = b_re + (g * 64 + p) * 16; const float* pim = b_im + (g * 64 + p) * 16;
    bf16* rre = btab + (size_t)((g * 2 + dir) * 128 + p) * 16; bf16* rim = btab + (size_t)((g * 2 + dir) * 128 + 64 + p) * 16;
#pragma unroll
    for (int c = 0; c < 16; ++c) { const float r = pre[c], i = pim[c]; rre[c] = (bf16)f2bf(cr * r - cim * i); rim[c] = (bf16)f2bf(cr * i + cim * r); }
}

__device__ __forceinline__ void row_load(const float* xrow, int lane, f32x4 (&v)[4]) {
    const GAS f32x4* xr = (const GAS f32x4*)xrow + lane;
#pragma unroll
    for (int j = 0; j < 4; ++j) v[j] = xr[64 * j];
}
__device__ __forceinline__ void row_norm(f32x4 (&v)[4]) {
    float s = 0.f;
#pragma unroll
    for (int j = 0; j < 4; ++j) s += (v[j].x + v[j].y) + (v[j].z + v[j].w);
    const float mean = wave_sum(s) * (1.f / D); float s2 = 0.f;
#pragma unroll
    for (int j = 0; j < 4; ++j) { v[j] = v[j] - mean; s2 += (v[j].x * v[j].x + v[j].y * v[j].y) + (v[j].z * v[j].z + v[j].w * v[j].w); }
    const float rstd = 1.f / sqrtf(wave_sum(s2) * (1.f / D) + LN_EPS);
#pragma unroll
    for (int j = 0; j < 4; ++j) v[j] = v[j] * rstd;
}
__device__ __forceinline__ void row_mod_store(const f32x4 (&v)[4], const float* sh, const float* scl, bf16* orow, int lane) {
    GAS unsigned long long* o8 = (GAS unsigned long long*)orow + lane;
#pragma unroll
    for (int j = 0; j < 4; ++j) { const f32x4 a = *((const GAS f32x4*)sh + lane + 64 * j), b = *((const GAS f32x4*)scl + lane + 64 * j);
        const f32x4 r = v[j] * (b + 1.f) + a;
        o8[64 * j] = (unsigned long long)pk2(r.x, r.y) | ((unsigned long long)pk2(r.z, r.w) << 32); }
}
__device__ __forceinline__ int cond_of_row(int m) { return m < NCTX ? 0 : 1 + ((m - NCTX) >> 11); }

struct RetUnit { int b, h, sc, row0, lu; bool ctx; };
__device__ __forceinline__ RetUnit ret_unit(int u) {
    RetUnit r; r.ctx = u < 64;
    if (r.ctx) { r.b = u >> 2; r.h = u & 3; r.sc = 0; r.row0 = r.b * 256; r.lu = 0; }
    else { const int lu = u - 64; r.lu = lu; r.b = lu >> 5; r.h = (lu >> 3) & 3; r.sc = lu & 7; r.row0 = NCTX + r.b * 2048 + r.sc * 256; }
    return r;
}
#define MFMA16(a, b, c) __builtin_amdgcn_mfma_f32_16x16x32_bf16((a), (b), (c), 0, 0, 0)

__device__ __forceinline__ void ret_states_unit(LAS unsigned char* lds, int u, int tid, const bf16* proj, const float* ret_decay, float* kvws, float* out_state) {
    const int lane = tid & 63, w = __builtin_amdgcn_readfirstlane(tid >> 6), fr = lane & 15, fq = lane >> 4;
    const RetUnit U = ret_unit(u);
    const float lgf = log2_sigmoid(ret_decay[U.h]), lgb = log2_sigmoid(ret_decay[4 + U.h]);
    LAS bf16* Vt = (LAS bf16*)lds; LAS bf16* Kft = (LAS bf16*)(lds + 18432); LAS bf16* Kbt = (LAS bf16*)(lds + 36864);
    f32x4 acc[2][8];
#pragma unroll
    for (int a = 0; a < 2; ++a)
#pragma unroll
        for (int c = 0; c < 8; ++c) acc[a][c] = (f32x4){0.f, 0.f, 0.f, 0.f};
    const int dir = w >> 2, dvb = (w & 3) * 32;
    for (int sl = 0; sl < 4; ++sl) {
        __syncthreads();
#pragma unroll
        for (int i = 0; i < 2; ++i) { const int idx = tid + 512 * i, tt = idx & 63, ch = idx >> 6, tl = 64 * sl + tt;
            const bf16* rp = proj + (size_t)(U.row0 + tl) * INC + U.h * 128 + ch * 8;
            const v4u kv = *(const GAS v4u*)(rp + 512), vv = *(const GAS v4u*)(rp + 1024);
            const float wf = exp2f((float)(255 - tl) * lgf), wb = exp2f((float)tl * lgb);
            const unsigned kw[4] = {kv.x, kv.y, kv.z, kv.w}, vw[4] = {vv.x, vv.y, vv.z, vv.w};
#pragma unroll
            for (int e = 0; e < 4; ++e) { const int r0 = (ch * 8 + 2 * e) * 72 + tt, r1 = r0 + 72;
                Vt[r0] = (bf16)(vw[e] & 0xffffu); Vt[r1] = (bf16)(vw[e] >> 16);
                const float k0 = bflo(kw[e]), k1 = bfhi(kw[e]);
                Kft[r0] = (bf16)f2bf(k0 * wf); Kft[r1] = (bf16)f2bf(k1 * wf); Kbt[r0] = (bf16)f2bf(k0 * wb); Kbt[r1] = (bf16)f2bf(k1 * wb); } }
        __syncthreads();
        const LAS bf16* Kt = dir ? Kbt : Kft;
        bf16x8 af[2][2];
#pragma unroll
        for (int rb = 0; rb < 2; ++rb)
#pragma unroll
            for (int ks = 0; ks < 2; ++ks) af[rb][ks] = *(const LAS bf16x8*)(Vt + (dvb + 16 * rb + fr) * 72 + 32 * ks + 8 * fq);
#pragma unroll
        for (int cb = 0; cb < 8; ++cb)
#pragma unroll
            for (int ks = 0; ks < 2; ++ks) { const bf16x8 bfr = *(const LAS bf16x8*)(Kt + (16 * cb + fr) * 72 + 32 * ks + 8 * fq);
#pragma unroll
                for (int rb = 0; rb < 2; ++rb) acc[rb][cb] = MFMA16(af[rb][ks], bfr, acc[rb][cb]); }
    }
    if (U.ctx) { float* o = out_state + (size_t)((U.b * 2 + dir) * 4 + U.h) * 16384;
#pragma unroll
        for (int rb = 0; rb < 2; ++rb)
#pragma unroll
            for (int cb = 0; cb < 8; ++cb) *(GAS f32x4*)(o + (16 * cb + fr) * 128 + dvb + 16 * rb + 4 * fq) = acc[rb][cb]; }
    else { float* o = kvws + ((size_t)U.lu * 2 + dir) * 16384;
#pragma unroll
        for (int rb = 0; rb < 2; ++rb)
#pragma unroll
            for (int cb = 0; cb < 8; ++cb)
#pragma unroll
                for (int r = 0; r < 4; ++r) o[(dvb + 16 * rb + 4 * fq + r) * 128 + 16 * cb + fr] = acc[rb][cb][r]; }
}

__device__ __forceinline__ bf16x8 scale8(bf16x8 q, float s) {
    bf16x8 r;
#pragma unroll
    for (int e = 0; e < 8; ++e) r[e] = (short)f2bf(bf2f((unsigned short)q[e]) * s);
    return r;
}
__device__ __forceinline__ void ret_out_unit(LAS unsigned char* lds, int u, int tid, const bf16* proj, const float* ret_decay, const float* kvws, const float* state_ret, bf16* mix) {
    const int lane = tid & 63, w = __builtin_amdgcn_readfirstlane(tid >> 6), fr = lane & 15, fq = lane >> 4;
    const RetUnit U = ret_unit(u);
    const float lgf = log2_sigmoid(ret_decay[U.h]), lgb = log2_sigmoid(ret_decay[4 + U.h]);
    LAS bf16* Ks = (LAS bf16*)lds;
    LAS bf16* Vt = (LAS bf16*)(lds + 17408);
    LAS bf16* Ps = (LAS bf16*)(lds + 35840 + w * 4608);
    bf16x8 qf[2][4];
#pragma unroll
    for (int rb = 0; rb < 2; ++rb)
#pragma unroll
        for (int ks = 0; ks < 4; ++ks) qf[rb][ks] = *(const GAS bf16x8*)(proj + (size_t)(U.row0 + 32 * w + 16 * rb + fr) * INC + U.h * 128 + 32 * ks + 8 * fq);
    f32x4 o[2][8];
#pragma unroll
    for (int a = 0; a < 2; ++a)
#pragma unroll
        for (int c = 0; c < 8; ++c) o[a][c] = (f32x4){0.f, 0.f, 0.f, 0.f};
    for (int j = 0; j < 4; ++j) {
        __syncthreads();
#pragma unroll
        for (int i = 0; i < 2; ++i) { const int idx = tid + 512 * i;
            { const int r = idx >> 4, ch = idx & 15;
              *(LAS v4u*)(Ks + r * 136 + ch * 8) = *(const GAS v4u*)(proj + (size_t)(U.row0 + 64 * j + r) * INC + 512 + U.h * 128 + ch * 8); }
            { const int tt = idx & 63, ch = idx >> 6;
              const v4u vv = *(const GAS v4u*)(proj + (size_t)(U.row0 + 64 * j + tt) * INC + 1024 + U.h * 128 + ch * 8);
              const unsigned vw[4] = {vv.x, vv.y, vv.z, vv.w};
#pragma unroll
              for (int e = 0; e < 4; ++e) { Vt[(ch * 8 + 2 * e) * 72 + tt] = (bf16)(vw[e] & 0xffffu); Vt[(ch * 8 + 2 * e + 1) * 72 + tt] = (bf16)(vw[e] >> 16); } } }
        __syncthreads();
#pragma unroll
        for (int cb = 0; cb < 4; ++cb) {
            bf16x8 kf[4];
#pragma unroll
            for (int ks = 0; ks < 4; ++ks) kf[ks] = *(const LAS bf16x8*)(Ks + (16 * cb + fr) * 136 + 32 * ks + 8 * fq);
#pragma unroll
            for (int rb = 0; rb < 2; ++rb) { f32x4 s = (f32x4){0.f, 0.f, 0.f, 0.f};
#pragma unroll
                for (int ks = 0; ks < 4; ++ks) s = MFMA16(qf[rb][ks], kf[ks], s);
#pragma unroll
                for (int r = 0; r < 4; ++r) { const int d = (32 * w + 16 * rb + 4 * fq + r) - (64 * j + 16 * cb + fr);
                    const float dec = d > 0 ? exp2f((float)d * lgf) : (d < 0 ? exp2f((float)(-d) * lgb) : 2.f);
                    Ps[(16 * rb + 4 * fq + r) * 72 + 16 * cb + fr] = (bf16)f2bf(s[r] * dec); } } }
        LDS_WAIT();
        bf16x8 pf[2][2];
#pragma unroll
        for (int rb = 0; rb < 2; ++rb)
#pragma unroll
            for (int ks = 0; ks < 2; ++ks) pf[rb][ks] = *(const LAS bf16x8*)(Ps + (16 * rb + fr) * 72 + 32 * ks + 8 * fq);
#pragma unroll
        for (int cb = 0; cb < 8; ++cb)
#pragma unroll
            for (int ks = 0; ks < 2; ++ks) { const bf16x8 vf = *(const LAS bf16x8*)(Vt + (16 * cb + fr) * 72 + 32 * ks + 8 * fq);
#pragma unroll
                for (int rb = 0; rb < 2; ++rb) o[rb][cb] = MFMA16(pf[rb][ks], vf, o[rb][cb]); }
    }
    if (!U.ctx) {
        for (int dir = 0; dir < 2; ++dir) {
            const float lg = dir ? lgb : lgf;
            float rs[2];
#pragma unroll
            for (int rb = 0; rb < 2; ++rb) { const int i = 32 * w + 16 * rb + fr; rs[rb] = exp2f((float)(dir ? (256 - i) : (i + 1)) * lg); }
            for (int s2 = 0; s2 < 2; ++s2) {
                __syncthreads();
                { const int dv = tid >> 2, q4 = tid & 3, dk0 = 64 * s2 + 16 * q4;
                  float a[16];
#pragma unroll
                  for (int e = 0; e < 16; ++e) a[e] = 0.f;
                  const int lub = U.lu & ~7;
                  const int lo = dir ? U.sc + 1 : 0, hi = dir ? 8 : U.sc;
                  for (int s = lo; s < hi; ++s) { const float wgt = exp2f(256.f * (float)(dir ? (s - U.sc - 1) : (U.sc - 1 - s)) * lg);
                      const float* p = kvws + ((size_t)(lub + s) * 2 + dir) * 16384 + dv * 128 + dk0;
#pragma unroll
                      for (int e4 = 0; e4 < 4; ++e4) { const f32x4 t = *(const GAS f32x4*)(p + 4 * e4); a[4 * e4] += wgt * t.x; a[4 * e4 + 1] += wgt * t.y; a[4 * e4 + 2] += wgt * t.z; a[4 * e4 + 3] += wgt * t.w; } }
                  { const float wgt0 = exp2f(256.f * (float)(dir ? (7 - U.sc) : U.sc) * lg);
                    const float* s0p = state_ret + (size_t)((U.b * 2 + dir) * 4 + U.h) * 16384 + dv;
#pragma unroll
                    for (int e = 0; e < 16; ++e) a[e] += wgt0 * s0p[(dk0 + e) * 128]; }
                  v4u w0, w1; w0.x = pk2(a[0], a[1]); w0.y = pk2(a[2], a[3]); w0.z = pk2(a[4], a[5]); w0.w = pk2(a[6], a[7]);
                  w1.x = pk2(a[8], a[9]); w1.y = pk2(a[10], a[11]); w1.z = pk2(a[12], a[13]); w1.w = pk2(a[14], a[15]);
                  *(LAS v4u*)(Vt + dv * 72 + 16 * q4) = w0; *(LAS v4u*)(Vt + dv * 72 + 16 * q4 + 8) = w1; }
                __syncthreads();
                bf16x8 qs[2][2];
#pragma unroll
                for (int rb = 0; rb < 2; ++rb) { qs[rb][0] = scale8(s2 ? qf[rb][2] : qf[rb][0], rs[rb]); qs[rb][1] = scale8(s2 ? qf[rb][3] : qf[rb][1], rs[rb]); }
#pragma unroll
                for (int cb = 0; cb < 8; ++cb)
#pragma unroll
                    for (int ks = 0; ks < 2; ++ks) { const bf16x8 vf = *(const LAS bf16x8*)(Vt + (16 * cb + fr) * 72 + 32 * ks + 8 * fq);
#pragma unroll
                        for (int rb = 0; rb < 2; ++rb) o[rb][cb] = MFMA16(qs[rb][ks], vf, o[rb][cb]); }
            }
        }
    }
#pragma unroll
    for (int rb = 0; rb < 2; ++rb)
#pragma unroll
        for (int r = 0; r < 4; ++r) {
            float s = 0.f;
#pragma unroll
            for (int cb = 0; cb < 8; ++cb) s += o[rb][cb][r];
            const float mean = sum16(s) * (1.f / 128.f); float q = 0.f;
#pragma unroll
            for (int cb = 0; cb < 8; ++cb) { const float d = o[rb][cb][r] - mean; q += d * d; }
            const float rstd = 1.f / sqrtf(sum16(q) * (1.f / 128.f) + LN_EPS);
            const size_t tok = (size_t)(U.row0 + 32 * w + 16 * rb + 4 * fq + r);
            const bf16* gp = proj + tok * INC + 1536 + U.h * 128 + fr; bf16* mp = mix + tok * D + U.h * 128 + fr;
#pragma unroll
            for (int cb = 0; cb < 8; ++cb) { const float g = bf2f(gp[16 * cb]); mp[16 * cb] = (bf16)f2bf((o[rb][cb][r] - mean) * rstd * siluf(g)); }
        }
}

struct S5Ptrs { const bf16* proj; const f32x2* abar; const f32x2* at; const bf16* btab; const bf16* ctab; f32x2* E; const float* s0_re; const float* s0_im; const float* dskip; bf16* yg; float* out_re; float* out_im; };
__device__ __forceinline__ void s5_task(const bool fin, LAS unsigned char* wl, int task, int lane, const S5Ptrs& P) {
    constexpr bool FINAL = true;
    const int crow = task >> 5, g = task & 31, fr = lane & 15, fq = lane >> 4;
    const bool ctx = crow < 64;
    const int b = ctx ? (crow >> 2) : ((crow - 64) >> 5), n = ctx ? (crow & 3) : ((crow - 64) & 31), nc = ctx ? 4 : 32, crow0 = crow - n;
    const int tok0 = crow * 64;
    LAS float* bu = (LAS float*)wl;
    LAS bf16* sb = (LAS bf16*)(wl + 8448);
    f32x4 yacc[4];
#pragma unroll
    for (int i = 0; i < 4; ++i) yacc[i] = (f32x4){0.f, 0.f, 0.f, 0.f};
    bf16x8 cf[4];
    if (FINAL) {
#pragma unroll
        for (int ks = 0; ks < 4; ++ks) cf[ks] = *(const GAS bf16x8*)(P.ctab + (size_t)(g * 16 + fr) * 128 + 32 * ks + 8 * fq);
    }
#pragma unroll
    for (int dir = 0; dir < 2; ++dir) {
        const int ti = (dir * 32 + g) * 64 + lane;
        const f32x2 ab = P.abar[ti];
        float sre = 0.f, sim = 0.f;
        if (FINAL) {
            const f32x2 A = P.at[ti];
            if (fin && !ctx) { const int si = ((b * 2 + dir) * 32 + g) * 64 + lane; sre = P.s0_re[si]; sim = P.s0_im[si]; }
            const f32x2* ep = P.E + ((size_t)(crow0 * 32 + g) * 2 + dir) * 64 + lane;
            f32x2 e[32];
#pragma unroll
            for (int j = 0; j < 32; ++j) e[j] = (j < nc) ? ep[(size_t)j * 4096] : (f32x2){0.f, 0.f};
#pragma unroll
            for (int jj = 0; jj < 32; ++jj) { const int j = dir ? 31 - jj : jj;
                const bool use = fin && (dir ? (j < nc && j > n) : (j < n));
                if (use) { const float nr = A.x * sre - A.y * sim + e[j].x, ni = A.x * sim + A.y * sre + e[j].y; sre = nr; sim = ni; } }
        }
        bf16x8 bfg[8];
#pragma unroll
        for (int cb = 0; cb < 8; ++cb) bfg[cb] = fq < 2 ? *(const GAS bf16x8*)(P.btab + (size_t)((g * 2 + dir) * 128 + cb * 16 + fr) * 16 + 8 * fq) : zero8();
#pragma unroll
        for (int si = 0; si < 4; ++si) {
            const int sub = dir ? 3 - si : si;
            const bf16x8 ua = fq < 2 ? *(const GAS bf16x8*)(P.proj + (size_t)(tok0 + 16 * sub + fr) * INC + 2048 + g * 16 + 8 * fq) : zero8();
#pragma unroll
            for (int cb = 0; cb < 8; ++cb) { const f32x4 a = MFMA16(ua, bfg[cb], ((f32x4){0.f, 0.f, 0.f, 0.f}));
#pragma unroll
                for (int r = 0; r < 4; ++r) bu[(4 * fq + r) * 132 + cb * 16 + fr] = a[r]; }
            LDS_WAIT();
            for (int i = 0; i < 16; ++i) { const int t = dir ? 15 - i : i;
                const float bre = bu[t * 132 + lane], bim = bu[t * 132 + 64 + lane];
                const float nr = ab.x * sre - ab.y * sim + bre, ni = ab.x * sim + ab.y * sre + bim; sre = nr; sim = ni;
                if (FINAL) { sb[t * 136 + lane] = (bf16)f2bf(sre); sb[t * 136 + 64 + lane] = (bf16)f2bf(sim); } }
            if (FINAL) {
                LDS_WAIT();
#pragma unroll
                for (int ks = 0; ks < 4; ++ks) { const bf16x8 sa = *(const LAS bf16x8*)(sb + fr * 136 + 32 * ks + 8 * fq); yacc[sub] = MFMA16(sa, cf[ks], yacc[sub]); }
            }
            LDS_WAIT();
        }
        if (!fin) P.E[((size_t)(crow * 32 + g) * 2 + dir) * 64 + lane] = (f32x2){sre, sim};
        else if (ctx && (dir ? n == 0 : n == nc - 1)) { const int oi = ((b * 2 + dir) * 32 + g) * 64 + lane; P.out_re[oi] = sre; P.out_im[oi] = sim; }
    }
    if (fin) {
        const float dsk = P.dskip[g * 16 + fr];
#pragma unroll
        for (int sub = 0; sub < 4; ++sub)
#pragma unroll
            for (int r = 0; r < 4; ++r) { const size_t tok = (size_t)(tok0 + 16 * sub + 4 * fq + r);
                const float uu = bf2f(P.proj[tok * INC + 2048 + g * 16 + fr]);
                P.yg[tok * SW + g * 16 + fr] = (bf16)f2bf(gelu_tanh(yacc[sub][r] + dsk * uu)); }
    }
}

struct Args { const float* in[30]; float* out; unsigned char* ws; };
__global__ void __launch_bounds__(NWAVES * 64, 2) fwd_kernel(Args args) {
    extern __shared__ __attribute__((aligned(16))) unsigned char lds_raw[];
    LAS unsigned char* lds = (LAS unsigned char*)lds_raw;
    volatile LAS unsigned* MISC = (volatile LAS unsigned*)(lds + MISC_OFF);
    const int tid = threadIdx.x, lane = tid & 63, wave = __builtin_amdgcn_readfirstlane(tid >> 6);
    const int G = gridDim.x, bid = blockIdx.x;
    const int gw = bid * NWAVES + wave, NGW = G * NWAVES;
    unsigned char* ws = args.ws;
    for (int u = tid; u < (LDS_BYTES - LDSCTL_OFF) / 4; u += NWAVES * 64) ((LAS unsigned*)(lds + LDSCTL_OFF))[u] = 0u;
    __syncthreads();
    XcdBarrier bar = xcd_barrier_post((unsigned*)(ws + WS_CTL) + CW_BAR, MISC + 8);

    const float* x_prompt = args.in[0]; const float* x_sample = args.in[1]; const float* state_ret = args.in[2];
    const float* state_s5_re = args.in[3]; const float* state_s5_im = args.in[4]; const float* c_lat = args.in[5]; const float* c_ctx = args.in[6];
    const float* w_ada = args.in[7]; const float* b_ada = args.in[8]; const float* w_in = args.in[9]; const float* ret_decay = args.in[10];
    const float* s5_a_re = args.in[11]; const float* s5_a_im = args.in[12]; const float* s5_log_dt = args.in[13];
    const float* s5_b_re = args.in[14]; const float* s5_b_im = args.in[15]; const float* s5_c_re = args.in[16]; const float* s5_c_im = args.in[17];
    const float* s5_d = args.in[18]; const float* w_glu = args.in[19]; const float* b_glu = args.in[20]; const float* w_out = args.in[21];
    const float* ln1_g = args.in[22]; const float* ln1_b = args.in[23]; const float* w_ff1 = args.in[24]; const float* b_ff1 = args.in[25];
    const float* w_ff2 = args.in[26]; const float* b_ff2 = args.in[27]; const float* ln2_g = args.in[28]; const float* ln2_b = args.in[29];
    float* out = args.out;
    float* out_y = out;
    float* out_state = out + (size_t)NTOK * D;
    float* out_s5re = out_state + (size_t)16 * 2 * 4 * 128 * 128;
    float* out_s5im = out_s5re + 16 * 2 * 32 * 64;

    float* mod = (float*)(ws + WS_MOD);
    f32x2* abar = (f32x2*)(ws + WS_ABAR); f32x2* atab = (f32x2*)(ws + WS_AT); bf16* btab = (bf16*)(ws + WS_BTAB); bf16* ctab = (bf16*)(ws + WS_CTAB);
    bf16* WinT = (bf16*)(ws + WS_WIN); bf16* WgluT = (bf16*)(ws + WS_WGLU); bf16* WoutT = (bf16*)(ws + WS_WOUT); bf16* Wff1T = (bf16*)(ws + WS_WFF1); bf16* Wff2T = (bf16*)(ws + WS_WFF2);
    bf16* H = (bf16*)(ws + WS_H); float* X1 = (float*)(ws + WS_X1); bf16* PROJ = (bf16*)(ws + WS_PROJ); float* KV = (float*)(ws + WS_KV);
    f32x2* E = (f32x2*)(ws + WS_E); bf16* MIX = (bf16*)(ws + WS_MIX); bf16* YG = (bf16*)(ws + WS_YG); bf16* FFH = (bf16*)(ws + WS_FFH);

    {
        for (int it = bid; it < 192; it += G) p0_mod_item(lds, it, tid, c_ctx, c_lat, w_ada, b_ada, mod);
        {
            const int t0 = bid * 512 + tid, TT = G * 512;
            for (int i = t0; i < 4096; i += TT) p0_tab_item(i, s5_a_re, s5_a_im, s5_log_dt, s5_b_re, s5_b_im, abar, atab, btab);
            for (int i = t0; i < 32768; i += TT) { const int gc = i >> 6, p = i & 63; ctab[gc * 128 + p] = (bf16)f2bf(s5_c_re[i]); ctab[gc * 128 + 64 + p] = (bf16)f2bf(-s5_c_im[i]); }
        }
        __syncthreads();
        LAS float* scr = (LAS float*)(lds + wave * 16384);
        constexpr int I_IN = (D / 64) * (INC / 32), I_GLU = (SW / 64) * (SW / 32), I_OUT = (D / 64) * (D / 32), I_F1 = (D / 64) * (FF / 32), I_F2 = (FF / 64) * (D / 32);
        constexpr int NITEMS = I_IN + I_GLU + I_OUT + I_F1 + I_F2;
        for (int it = gw; it < NITEMS; it += NGW) {
            int r = it;
            if (r < I_IN) { p0_transpose_item(w_in, D, INC, WinT, scr, r, lane, 512, 1024, KSCALE); continue; } r -= I_IN;
            if (r < I_GLU) { p0_transpose_item(w_glu, SW, SW, WgluT, scr, r, lane, 0, 0, 1.f); continue; } r -= I_GLU;
            if (r < I_OUT) { p0_transpose_item(w_out, D, D, WoutT, scr, r, lane, 0, 0, 1.f); continue; } r -= I_OUT;
            if (r < I_F1) { p0_transpose_item(w_ff1, D, FF, Wff1T, scr, r, lane, 0, 0, 1.f); continue; } r -= I_F1;
            p0_transpose_item(w_ff2, FF, D, Wff2T, scr, r, lane, 0, 0, 1.f);
        }
    }
    xcd_barrier(bar);

    for (int m = gw; m < NTOK; m += NGW) {
        const float* xr = m < NCTX ? x_prompt + (size_t)m * D : x_sample + (size_t)(m - NCTX) * D;
        const float* mp = mod + cond_of_row(m) * 6144;
        f32x4 v[4]; row_load(xr, lane, v); row_norm(v); row_mod_store(v, mp, mp + 1024, H + (size_t)m * D, lane);
    }
    xcd_barrier(bar);

    {
        pg8::Gemm g{H, WinT, NTOK, INC, D}; pg8::StaticOrder S; S.init(NTOK, INC, G, bid);
        pg8::EpiBf16<0> Ep{PROJ, INC, nullptr, 0, 0, 1.f};
        pg8::gemm_phase<pg8::EpiBf16<0>, pg8::StaticOrder, PG8_ALIGN, PG8_SP2>(lds, g, S, Ep);
    }
    xcd_barrier(bar);

    S5Ptrs SP{PROJ, abar, atab, btab, ctab, E, state_s5_re, state_s5_im, s5_d, YG, out_s5re, out_s5im};
    for (int u = bid; u < N_RET_UNITS; u += G) ret_states_unit(lds, u, tid, PROJ, ret_decay, KV, out_state);
    __syncthreads();
    for (int t = gw; t < N_S5_TASKS; t += NGW) s5_task(false, lds + wave * 12800, t, lane, SP);
    xcd_barrier(bar);

    for (int u = bid; u < N_RET_UNITS; u += G) ret_out_unit(lds, u, tid, PROJ, ret_decay, KV, state_ret, MIX);
    __syncthreads();
    for (int t = gw; t < N_S5_TASKS; t += NGW) s5_task(true, lds + wave * 12800, t, lane, SP);
    xcd_barrier(bar);

    {
        pg8::Gemm g{YG, WgluT, NTOK, SW, SW}; pg8::StaticOrder S; S.init(NTOK, SW, G, bid);
        pg8::EpiGlu Ep{YG, SW, MIX, D, 512, b_glu};
        pg8::gemm_phase<pg8::EpiGlu, pg8::StaticOrder, PG8_ALIGN, PG8_SP2>(lds, g, S, Ep);
    }
    xcd_barrier(bar);

    {
        pg8::Gemm g{MIX, WoutT, NTOK, D, D}; pg8::StaticOrder S; S.init(NTOK, D, G, bid);
        pg8::EpiRes Ep{x_prompt, x_sample, out_y, nullptr, mod, 2048, ALPHA};
        pg8::gemm_phase<pg8::EpiRes, pg8::StaticOrder, PG8_ALIGN, PG8_SP2>(lds, g, S, Ep);
    }
    xcd_barrier(bar);

    for (int m = gw; m < NTOK; m += NGW) {
        const float* mp = mod + cond_of_row(m) * 6144;
        f32x4 v[4]; row_load(out_y + (size_t)m * D, lane, v); row_norm(v);
        GAS f32x4* xo = (GAS f32x4*)(X1 + (size_t)m * D) + lane;
#pragma unroll
        for (int j = 0; j < 4; ++j) { v[j] = v[j] * *((const GAS f32x4*)ln1_g + lane + 64 * j) + *((const GAS f32x4*)ln1_b + lane + 64 * j); xo[64 * j] = v[j]; }
        row_norm(v); row_mod_store(v, mp + 3072, mp + 4096, H + (size_t)m * D, lane);
    }
    xcd_barrier(bar);

    {
        pg8::Gemm g{H, Wff1T, NTOK, FF, D}; pg8::StaticOrder S; S.init(NTOK, FF, G, bid);
        pg8::EpiSqRelu Ep{FFH, FF, b_ff1};
        pg8::gemm_phase<pg8::EpiSqRelu, pg8::StaticOrder, PG8_ALIGN, PG8_SP2>(lds, g, S, Ep);
    }
    xcd_barrier(bar);

    {
        pg8::Gemm g{FFH, Wff2T, NTOK, D, FF}; pg8::StaticOrder S; S.init(NTOK, D, G, bid);
        pg8::EpiRes Ep{X1, X1 + (size_t)NCTX * D, out_y, b_ff2, mod, 5120, ALPHA};
        pg8::gemm_phase<pg8::EpiRes, pg8::StaticOrder, PG8_ALIGN, PG8_SP2>(lds, g, S, Ep);
    }
    xcd_barrier(bar);

    for (int m = gw; m < NTOK; m += NGW) {
        f32x4 v[4]; row_load(out_y + (size_t)m * D, lane, v); row_norm(v);
        GAS f32x4* yo = (GAS f32x4*)(out_y + (size_t)m * D) + lane;
#pragma unroll
        for (int j = 0; j < 4; ++j) yo[64 * j] = v[j] * *((const GAS f32x4*)ln2_g + lane + 64 * j) + *((const GAS f32x4*)ln2_b + lane + 64 * j);
    }
}

extern "C" void kernel_launch(void* const* d_in, const int* in_sizes, int n_in, void* d_out, int out_size, void* d_ws, size_t ws_size, hipStream_t stream) {
    static int grid = 0;
    if (grid == 0) {
        if (n_in != 30 || ws_size < WS_END) { fprintf(stderr, "kernel_launch: built for 30 inputs and >= %zu bytes of workspace; got n_in %d, ws %zu; nothing launched\n", (size_t)WS_END, n_in, ws_size); grid = -1; return; }
        int dev = 0, cus = 0, per_cu = 0;
        if (hipGetDevice(&dev) != hipSuccess || hipDeviceGetAttribute(&cus, hipDeviceAttributeMultiprocessorCount, dev) != hipSuccess) { fprintf(stderr, "kernel_launch: device query failed\n"); grid = -1; return; }
        if (hipFuncSetAttribute((const void*)fwd_kernel, hipFuncAttributeMaxDynamicSharedMemorySize, LDS_BYTES) != hipSuccess) { fprintf(stderr, "kernel_launch: hipFuncSetAttribute failed\n"); grid = -1; return; }
        if (hipOccupancyMaxActiveBlocksPerMultiprocessor(&per_cu, (const void*)fwd_kernel, NWAVES * 64, LDS_BYTES) != hipSuccess || per_cu < 1) {
            fprintf(stderr, "kernel_launch: occupancy query reports %d workgroups per CU; nothing launched\n", per_cu); (void)hipGetLastError(); grid = -1; return; }
        grid = cus;
    }
    if (grid < 0) return;
    (void)hipMemsetAsync((char*)d_ws + WS_CTL, 0, CTL_ZERO_BYTES, stream);
    Args a{};
    for (int i = 0; i < 30; ++i) a.in[i] = (const float*)d_in[i];
    a.out = (float*)d_out; a.ws = (unsigned char*)d_ws;
    hipLaunchKernelGGL(fwd_kernel, dim3(grid), dim3(NWAVES * 64), LDS_BYTES, stream, a);
}
```

```cpp
#include <hip/hip_runtime.h>
#include <cstdio>
#include <cstdint>
namespace pg8 {
#define PG8_LAS __attribute__((address_space(3)))
typedef unsigned short bf16_t;
typedef short bf16x8 __attribute__((ext_vector_type(8)));
typedef float f32x4 __attribute__((ext_vector_type(4)));
typedef unsigned u32x4 __attribute__((ext_vector_type(4)));
constexpr int BM = 256, BK = 64, HALF = 128, HTB = HALF * BK * 2  , STAGE_BYTES = 8 * HTB, NXCD = 8, WGM = 8;

__host__ __device__ __forceinline__ int lds_byte(int r, int c) { const int st = (r >> 4) * 2 + (c >> 5), rr = r & 15, cc = c & 31, ob = rr * 64 + cc * 2; return st * 1024 + (ob ^ (((ob >> 9) & 1) << 5)); }
__host__ __device__ __forceinline__ void stage_rc(int b, int& R, int& C) { const int st = b / 1024, sb = b % 1024, swz = sb ^ (((sb >> 9) & 1) << 5); R = (st >> 1) * 16 + swz / 64; C = (st & 1) * 32 + (swz % 64) / 2; }
__host__ __device__ __forceinline__ int perm32(int rho) { const int n = rho >> 4, i = rho & 15; return 8 * (i >> 2) + 4 * n + (i & 3); }

struct Unit { int pm, pn; };
struct Gemm { const bf16_t* A; const bf16_t* Bt; int M, N, K; };

struct StaticOrder {
    int nM, nN, nwg, G, c;
    __host__ __device__ void init(int M, int N, int G_, int c_) { nM = M / BM; nN = N / BM; nwg = nM * nN; G = G_; c = c_; }
    __host__ __device__ bool next(int i, Unit& u) const {
        const long L = (long)i * G + c; if (L >= nwg) return false;
        int wgid = (int)L; { const int q = nwg / NXCD, r = nwg % NXCD, xcd = wgid % NXCD, off = wgid / NXCD; wgid = (xcd < r ? xcd * (q + 1) : r * (q + 1) + (xcd - r) * q) + off; }
        const int nig = WGM * nN, gid = wgid / nig, fm = gid * WGM, gsz = (nM - fm) < WGM ? (nM - fm) : WGM;
        u.pm = fm + ((wgid % nig) % gsz); u.pn = (wgid % nig) / gsz; return true;
    }
    __device__ __forceinline__ void a_ready(const Unit&) const {}
    __device__ __forceinline__ void done(const Unit&) const {}
};

__device__ __forceinline__ unsigned cvt_pk_bf16(float lo, float hi) { unsigned r; asm volatile("v_cvt_pk_bf16_f32 %0, %1, %2" : "=v"(r) : "v"(lo), "v"(hi)); return r; }
typedef float f32x2 __attribute__((ext_vector_type(2)));
__device__ __forceinline__ f32x2 gelu_pk(f32x2 v) {
    const f32x2 av = __builtin_elementwise_abs(v), d = av * 0.2316418882f + 1.0f;
    f32x2 t; t.x = __builtin_amdgcn_rcpf(d.x); t.y = __builtin_amdgcn_rcpf(d.y);
    f32x2 q = t * 0.5307027145f + (-0.7265760135f); q = q * t + 0.7107068705f; q = q * t + (-0.142248368f); q = q * t + 0.127414796f; q = q * t;
    const f32x2 s = (v * v) * (-0.72134752044f);
    f32x2 e; e.x = __builtin_amdgcn_exp2f(s.x); e.y = __builtin_amdgcn_exp2f(s.y);
    const f32x2 m = v * (q * e), r = v - m;
    f32x2 o; o.x = v.x < 0.f ? m.x : r.x; o.y = v.y < 0.f ? m.y : r.y; return o;
}

template <int ACT  > struct EpiBf16 {
    static constexpr bool PERM = true, AFTER_DRAIN = false; static_assert(ACT == 0 || ACT == 1, "EpiBf16: ACT is 0 (none) or 1 (gelu_pk)");
    bf16_t* O; int ldc; const float* bias; int split_cols; size_t split_stride; float scale0;
    __device__ __forceinline__ void operator()(const f32x4 (&acc)[2][2][4][2], const Unit& u, int wr, int wc, int fr, int fq) const {
        const int row0 = u.pm * BM + wr * 64 + fr; int colt = u.pn * BM; bf16_t* base = O;
        float sc = 1.f; if (split_cols) { const int t = colt / split_cols; base += (size_t)t * split_stride; colt -= t * split_cols; if (t == 0) sc = scale0; }
        const int col0 = colt + wc * 32 + 8 * fq, bcol0 = u.pn * BM + wc * 32 + 8 * fq;
        f32x4 bv[2][2];
#pragma unroll
        for (int bj = 0; bj < 2; ++bj)
#pragma unroll
            for (int n = 0; n < 2; ++n) bv[bj][n] = bias ? *(const f32x4*)(bias + bcol0 + bj * HALF + 4 * n) : (f32x4){0.f, 0.f, 0.f, 0.f};
#pragma unroll
        for (int ai = 0; ai < 2; ++ai)
#pragma unroll
            for (int m = 0; m < 4; ++m) { bf16_t* rowp = base + (size_t)(row0 + ai * HALF + m * 16) * ldc + col0;
#pragma unroll
                for (int bj = 0; bj < 2; ++bj) { f32x4 v0 = acc[ai][bj][m][0] + bv[bj][0], v1 = acc[ai][bj][m][1] + bv[bj][1];
                    if (ACT == 1) { f32x2 a = gelu_pk((f32x2){v0[0], v0[1]}), b = gelu_pk((f32x2){v0[2], v0[3]}), c = gelu_pk((f32x2){v1[0], v1[1]}), d = gelu_pk((f32x2){v1[2], v1[3]});
                        v0 = (f32x4){a.x, a.y, b.x, b.y}; v1 = (f32x4){c.x, c.y, d.x, d.y}; }
                    v0 = v0 * sc; v1 = v1 * sc; u32x4 w; w.x = cvt_pk_bf16(v0[0], v0[1]); w.y = cvt_pk_bf16(v0[2], v0[3]); w.z = cvt_pk_bf16(v1[0], v1[1]); w.w = cvt_pk_bf16(v1[2], v1[3]);
                    *(u32x4*)(rowp + bj * HALF) = w; } }
    }
};
struct EpiSqRelu {
    static constexpr bool PERM = true, AFTER_DRAIN = false;
    bf16_t* O; int ldc; const float* bias;
    __device__ __forceinline__ void operator()(const f32x4 (&acc)[2][2][4][2], const Unit& u, int wr, int wc, int fr, int fq) const {
        const int row0 = u.pm * BM + wr * 64 + fr; const int col0 = u.pn * BM + wc * 32 + 8 * fq;
        f32x4 bv[2][2];
#pragma unroll
        for (int bj = 0; bj < 2; ++bj)
#pragma unroll
            for (int n = 0; n < 2; ++n) bv[bj][n] = *(const f32x4*)(bias + col0 + bj * HALF + 4 * n);
#pragma unroll
        for (int ai = 0; ai < 2; ++ai)
#pragma unroll
            for (int m = 0; m < 4; ++m) { bf16_t* rowp = O + (size_t)(row0 + ai * HALF + m * 16) * ldc + col0;
#pragma unroll
                for (int bj = 0; bj < 2; ++bj) { f32x4 v0 = acc[ai][bj][m][0] + bv[bj][0], v1 = acc[ai][bj][m][1] + bv[bj][1];
#pragma unroll
                    for (int e = 0; e < 4; ++e) { const float a = fmaxf(v0[e], 0.f), b = fmaxf(v1[e], 0.f); v0[e] = a * a; v1[e] = b * b; }
                    u32x4 w; w.x = cvt_pk_bf16(v0[0], v0[1]); w.y = cvt_pk_bf16(v0[2], v0[3]); w.z = cvt_pk_bf16(v1[0], v1[1]); w.w = cvt_pk_bf16(v1[2], v1[3]);
                    *(u32x4*)(rowp + bj * HALF) = w; } }
    }
};
struct EpiGlu {
    static constexpr bool PERM = true, AFTER_DRAIN = false;
    const bf16_t* Y; int ldy; bf16_t* O; int ldo; int ocol0; const float* bias;
    __device__ __forceinline__ void operator()(const f32x4 (&acc)[2][2][4][2], const Unit& u, int wr, int wc, int fr, int fq) const {
        const int row0 = u.pm * BM + wr * 64 + fr; const int col0 = u.pn * BM + wc * 32 + 8 * fq;
        f32x4 bv[2][2];
#pragma unroll
        for (int bj = 0; bj < 2; ++bj)
#pragma unroll
            for (int n = 0; n < 2; ++n) bv[bj][n] = *(const f32x4*)(bias + col0 + bj * HALF + 4 * n);
#pragma unroll
        for (int ai = 0; ai < 2; ++ai)
#pragma unroll
            for (int m = 0; m < 4; ++m) { const size_t row = (size_t)(row0 + ai * HALF + m * 16);
#pragma unroll
                for (int bj = 0; bj < 2; ++bj) { const f32x4 v0 = acc[ai][bj][m][0] + bv[bj][0], v1 = acc[ai][bj][m][1] + bv[bj][1];
                    const u32x4 yv = *(const u32x4*)(Y + row * ldy + col0 + bj * HALF);
                    float y[8]; y[0] = __uint_as_float(yv.x << 16); y[1] = __uint_as_float(yv.x & 0xffff0000u); y[2] = __uint_as_float(yv.y << 16); y[3] = __uint_as_float(yv.y & 0xffff0000u);
                    y[4] = __uint_as_float(yv.z << 16); y[5] = __uint_as_float(yv.z & 0xffff0000u); y[6] = __uint_as_float(yv.w << 16); y[7] = __uint_as_float(yv.w & 0xffff0000u);
                    float o[8];
#pragma unroll
                    for (int e = 0; e < 4; ++e) { o[e] = y[e] / (1.f + __expf(-v0[e])); o[4 + e] = y[4 + e] / (1.f + __expf(-v1[e])); }
                    u32x4 w; w.x = cvt_pk_bf16(o[0], o[1]); w.y = cvt_pk_bf16(o[2], o[3]); w.z = cvt_pk_bf16(o[4], o[5]); w.w = cvt_pk_bf16(o[6], o[7]);
                    *(u32x4*)(O + row * ldo + ocol0 + col0 + bj * HALF) = w; } }
    }
};
struct EpiRes {
    static constexpr bool PERM = false, AFTER_DRAIN = false;
    const float* xlo; const float* xhi; float* Z; const float* bias; const float* mod; int goff; float alpha;
    __device__ __forceinline__ void operator()(const f32x4 (&acc)[2][2][4][2], const Unit& u, int wr, int wc, int fr, int fq) const {
        const int row0 = u.pm * BM + wr * 64 + fr, col0 = u.pn * BM + wc * 32 + 4 * fq;
        const int ci = u.pm < 16 ? 0 : 1 + ((u.pm - 16) >> 3);
        const float* gp = mod + ci * 6144 + goff;
        f32x4 bv[2][2], gv[2][2];
#pragma unroll
        for (int bj = 0; bj < 2; ++bj)
#pragma unroll
            for (int n = 0; n < 2; ++n) { bv[bj][n] = bias ? *(const f32x4*)(bias + col0 + bj * HALF + n * 16) : (f32x4){0.f, 0.f, 0.f, 0.f}; gv[bj][n] = *(const f32x4*)(gp + col0 + bj * HALF + n * 16); }
#pragma unroll
        for (int ai = 0; ai < 2; ++ai)
#pragma unroll
            for (int m = 0; m < 4; ++m) { const int row = row0 + ai * HALF + m * 16;
                const float* xr = (row < 4096 ? xlo + (size_t)row * 1024 : xhi + (size_t)(row - 4096) * 1024) + col0; float* zr = Z + (size_t)row * 1024 + col0;
#pragma unroll
                for (int bj = 0; bj < 2; ++bj)
#pragma unroll
                    for (int n = 0; n < 2; ++n) { const f32x4 xv = *(const f32x4*)(xr + bj * HALF + n * 16);
                        *(f32x4*)(zr + bj * HALF + n * 16) = xv * alpha + gv[bj][n] * (acc[ai][bj][m][n] + bv[bj][n]); } }
    }
};
template <class Epi, class Sched, bool ALIGN_EPI = false, bool SP2 = false>
__device__ __forceinline__ void gemm_phase(PG8_LAS unsigned char* lds, const Gemm g, const Sched& S, const Epi& E) {
    int tid_ = threadIdx.x; asm volatile("" : "+v"(tid_));
    const int tid = tid_, wid = __builtin_amdgcn_readfirstlane(tid >> 6), lane = tid & 63, wr = wid >> 2, wc = wid & 3, fr = lane & 15, fq = lane >> 4;
    const int K = g.K, nt = K / BK;
    unsigned voffA[2], voffB[2];
#pragma unroll
    for (int i = 0; i < 2; ++i) { int R, C; stage_rc(tid * 16 + i * 8192, R, C); const int Rb = Epi::PERM ? ((R & ~31) + perm32(R & 31)) : R;
        voffA[i] = (unsigned)(R * K + C) * 2u; voffB[i] = (unsigned)(Rb * K + C) * 2u; }
    const size_t kstep = (size_t)(BK * 2);
    const size_t hstep = (size_t)HALF * K * 2;
    const size_t tstep = 2 * hstep;
    const unsigned ldsw = (unsigned)wid * 1024u;
    const int aoff = lds_byte(wr * 64 + fr, fq * 8), boff = lds_byte(wc * 32 + fr, fq * 8);
#define PG8_SA(b, h) (((b) * 2 + (h)) * HTB)
#define PG8_SB(b, h) ((4 + (b) * 2 + (h)) * HTB)
#define PG8_STAGE(bufoff, gbase, voff) do { _Pragma("unroll") for (int _i = 0; _i < 2; ++_i) \
        __builtin_amdgcn_global_load_lds((const unsigned*)((const char*)(gbase) + (voff)[_i]), (PG8_LAS unsigned*)(lds + (bufoff) + ldsw + _i * 8192), 16, 0, 0); } while (0)
#define PG8_LDA(dst, b, h) do { _Pragma("unroll") for (int m = 0; m < 4; ++m) _Pragma("unroll") for (int k = 0; k < 2; ++k) dst[m][k] = *(const PG8_LAS bf16x8*)(lds + PG8_SA(b, h) + aoff + m * 2048 + k * 1024); } while (0)
#define PG8_LDB(dst, b, h) do { _Pragma("unroll") for (int n = 0; n < 2; ++n) _Pragma("unroll") for (int k = 0; k < 2; ++k) dst[n][k] = *(const PG8_LAS bf16x8*)(lds + PG8_SB(b, h) + boff + n * 2048 + k * 1024); } while (0)
#define PG8_MMA(ai, bj, At, Bt) do { __builtin_amdgcn_s_setprio(1); _Pragma("unroll") for (int m = 0; m < 4; ++m) _Pragma("unroll") for (int n = 0; n < 2; ++n) _Pragma("unroll") for (int k = 0; k < 2; ++k) \
        acc[ai][bj][m][n] = __builtin_amdgcn_mfma_f32_16x16x32_bf16(Bt[n][k], At[m][k], acc[ai][bj][m][n], 0, 0, 0); __builtin_amdgcn_s_setprio(0); } while (0)
#define PG8_WAIT_V(n) asm volatile("s_waitcnt vmcnt(" #n ")" ::: "memory")
#define PG8_WAIT_L(n) asm volatile("s_waitcnt lgkmcnt(" #n ")" ::: "memory")
#define PG8_BAR __builtin_amdgcn_s_barrier()
#define PG8_SCHED __builtin_amdgcn_sched_barrier(0)
    Unit cur, nxt; int ui = 0;
    if (!S.next(0, cur)) return;
    f32x4 acc[2][2][4][2];
#pragma unroll
    for (int a = 0; a < 2; ++a)
#pragma unroll
        for (int b = 0; b < 2; ++b)
#pragma unroll
            for (int m = 0; m < 4; ++m)
#pragma unroll
                for (int n = 0; n < 2; ++n) acc[a][b][m][n] = (f32x4){0.f, 0.f, 0.f, 0.f};
    bf16x8 At[4][2], B0[2][2], B1[2][2];
    const char* cA = (const char*)g.A + (size_t)cur.pm * tstep; const char* cB = (const char*)g.Bt + (size_t)cur.pn * tstep;
    S.a_ready(cur);
    if constexpr (SP2) {
        PG8_STAGE(PG8_SB(0, 0), cB, voffB); PG8_STAGE(PG8_SB(0, 1), cB + hstep, voffB); PG8_STAGE(PG8_SA(0, 0), cA, voffA); PG8_STAGE(PG8_SA(0, 1), cA + hstep, voffA);
        if (wr == 1) PG8_BAR;
        PG8_WAIT_V(2); PG8_BAR;
        PG8_STAGE(PG8_SB(1, 0), cB + kstep, voffB); PG8_STAGE(PG8_SA(1, 0), cA + kstep, voffA); PG8_STAGE(PG8_SB(1, 1), cB + hstep + kstep, voffB);
        PG8_WAIT_V(6); PG8_BAR;
    } else {
        PG8_STAGE(PG8_SB(0, 0), cB, voffB); PG8_STAGE(PG8_SA(0, 0), cA, voffA); PG8_STAGE(PG8_SB(0, 1), cB + hstep, voffB); PG8_STAGE(PG8_SA(0, 1), cA + hstep, voffA);
        if (wr == 1) PG8_BAR;
        PG8_WAIT_V(4); PG8_BAR;
        PG8_STAGE(PG8_SB(1, 0), cB + kstep, voffB); PG8_STAGE(PG8_SA(1, 0), cA + kstep, voffA); PG8_STAGE(PG8_SB(1, 1), cB + hstep + kstep, voffB);
        PG8_WAIT_V(6); PG8_BAR;
    }
    for (;;) {
        const bool has_next = S.next(ui + 1, nxt);
        const char* nA = has_next ? (const char*)g.A + (size_t)nxt.pm * tstep : cA; const char* nB = has_next ? (const char*)g.Bt + (size_t)nxt.pn * tstep : cB;
        for (int t = 0; t < nt; t += 2) {
            const bool last = (t == nt - 2);
            const char* a1 = cA + (size_t)(t + 1) * kstep;
            const char* a2 = last ? nA : cA + (size_t)(t + 2) * kstep; const char* b2 = last ? nB : cB + (size_t)(t + 2) * kstep;
            const char* a3 = a2 + kstep; const char* b3 = b2 + kstep;
            if (last && has_next) S.a_ready(nxt);
            if constexpr (SP2) {
            PG8_LDB(B0, 0, 0); PG8_LDB(B1, 0, 1); PG8_SCHED; PG8_LDA(At, 0, 0); PG8_STAGE(PG8_SA(1, 1), a1 + hstep, voffA);
            PG8_WAIT_V(8); PG8_WAIT_L(0); PG8_BAR; PG8_MMA(0, 0, At, B0); PG8_MMA(0, 1, At, B1); PG8_BAR; PG8_SCHED;
            PG8_LDA(At, 0, 1); PG8_STAGE(PG8_SB(0, 0), b2, voffB); PG8_STAGE(PG8_SB(0, 1), b2 + hstep, voffB); PG8_STAGE(PG8_SA(0, 0), a2, voffA);
            PG8_WAIT_V(8); PG8_WAIT_L(0); PG8_BAR; PG8_MMA(1, 0, At, B0); PG8_MMA(1, 1, At, B1); PG8_BAR; PG8_SCHED;
            PG8_LDB(B0, 1, 0); PG8_LDB(B1, 1, 1); PG8_SCHED; PG8_LDA(At, 1, 0); PG8_STAGE(PG8_SA(0, 1), a2 + hstep, voffA);
            PG8_WAIT_V(8); PG8_WAIT_L(0); PG8_BAR; PG8_MMA(0, 0, At, B0); PG8_MMA(0, 1, At, B1); PG8_BAR; PG8_SCHED;
            PG8_LDA(At, 1, 1); PG8_STAGE(PG8_SB(1, 0), b3, voffB); PG8_STAGE(PG8_SB(1, 1), b3 + hstep, voffB); PG8_STAGE(PG8_SA(1, 0), a3, voffA);
            PG8_WAIT_V(8); PG8_WAIT_L(0); PG8_BAR; PG8_MMA(1, 0, At, B0); PG8_MMA(1, 1, At, B1); PG8_BAR; PG8_SCHED;
            } else {
            PG8_LDB(B0, 0, 0); PG8_SCHED; PG8_LDA(At, 0, 0); PG8_STAGE(PG8_SA(1, 1), a1 + hstep, voffA);
            PG8_WAIT_L(8); PG8_BAR; PG8_WAIT_L(0); PG8_MMA(0, 0, At, B0); PG8_BAR; PG8_SCHED;
            PG8_LDB(B1, 0, 1); PG8_STAGE(PG8_SB(0, 0), b2, voffB);
            PG8_BAR; PG8_WAIT_L(0); PG8_MMA(0, 1, At, B1); PG8_BAR;
            PG8_LDA(At, 0, 1); PG8_STAGE(PG8_SA(0, 0), a2, voffA);
            PG8_BAR; PG8_WAIT_L(0); PG8_MMA(1, 0, At, B0); PG8_BAR; PG8_SCHED;
            PG8_STAGE(PG8_SB(0, 1), b2 + hstep, voffB);
            PG8_WAIT_V(6); PG8_BAR; PG8_MMA(1, 1, At, B1); PG8_BAR;
            PG8_LDB(B0, 1, 0); PG8_SCHED; PG8_LDA(At, 1, 0); PG8_STAGE(PG8_SA(0, 1), a2 + hstep, voffA);
            PG8_WAIT_L(8); PG8_BAR; PG8_WAIT_L(0); PG8_MMA(0, 0, At, B0); PG8_BAR; PG8_SCHED;
            PG8_LDB(B1, 1, 1); PG8_STAGE(PG8_SB(1, 0), b3, voffB);
            PG8_BAR; PG8_WAIT_L(0); PG8_MMA(0, 1, At, B1); PG8_BAR;
            PG8_LDA(At, 1, 1); PG8_STAGE(PG8_SA(1, 0), a3, voffA);
            PG8_BAR; PG8_WAIT_L(0); PG8_MMA(1, 0, At, B0); PG8_BAR; PG8_SCHED;
            PG8_STAGE(PG8_SB(1, 1), b3 + hstep, voffB);
            PG8_WAIT_V(6); PG8_BAR; PG8_MMA(1, 1, At, B1); PG8_BAR;
            }
        }
        if constexpr (ALIGN_EPI) { if (wr == 0) PG8_BAR; }
        if constexpr (!Epi::AFTER_DRAIN) { E(acc, cur, wr, wc, fr, fq); S.done(cur); }
        if (!has_next) break;
#pragma unroll
        for (int a = 0; a < 2; ++a)
#pragma unroll
            for (int b = 0; b < 2; ++b)
#pragma unroll
                for (int m = 0; m < 4; ++m)
#pragma unroll
                    for (int n = 0; n < 2; ++n) acc[a][b][m][n] = (f32x4){0.f, 0.f, 0.f, 0.f};
        cur = nxt; cA = nA; cB = nB; ++ui;
        if constexpr (ALIGN_EPI) { if (wr == 1) PG8_BAR; }
    }
    PG8_WAIT_V(0);
    if constexpr (!ALIGN_EPI) { if (wr == 0) PG8_BAR; }
    PG8_BAR;
    if constexpr (Epi::AFTER_DRAIN) { E.fused(acc, cur, wr, wc, fr, fq, lds, wid, lane); S.done(cur); }
#undef PG8_SA
#undef PG8_SB
#undef PG8_STAGE
#undef PG8_LDA
#undef PG8_LDB
#undef PG8_MMA
#undef PG8_WAIT_V
#undef PG8_WAIT_L
#undef PG8_BAR
#undef PG8_SCHED
}
}
#ifndef PG8_SP2
#define PG8_SP2 true
#endif
#ifndef PG8_ALIGN
#define PG8_ALIGN true
#endif
constexpr int NWAVES = 8;
constexpr int D = 1024, NTOK = 12288, NCTX = 4096, INC = 2560, FF = 4096, SW = 512;
constexpr int N_RET_UNITS = 192;
constexpr int N_S5_ITEMS = 192;
constexpr float LN_EPS = 1e-5f;
constexpr float ALPHA = 1.18920711500272f;
constexpr float KSCALE = 0.08838834764831845f;
constexpr float LOG2E = 1.4426950408889634f;

constexpr size_t MiB = 1u << 20;
constexpr size_t WS_CTL = 0, CTL_ZERO_BYTES = 64 * 1024;
constexpr size_t WS_MOD = 1 * MiB;
constexpr size_t WS_ABAR = 2 * MiB, WS_AT = WS_ABAR + 64 * 1024, WS_BTAB = WS_ABAR + 128 * 1024, WS_CTAB = WS_ABAR + 512 * 1024;
constexpr size_t WS_WIN = 4 * MiB, WS_WGLU = 9 * MiB, WS_WOUT = 10 * MiB, WS_WFF1 = 12 * MiB, WS_WFF2 = 20 * MiB;
constexpr size_t WS_H = 28 * MiB;
constexpr size_t WS_X1 = 52 * MiB;
constexpr size_t WS_PROJ = 100 * MiB;
constexpr size_t WS_KV = 160 * MiB;
constexpr size_t WS_E = 176 * MiB;
constexpr size_t WS_MIX = 184 * MiB;
constexpr size_t WS_YG = 208 * MiB;
constexpr size_t WS_FFH = 100 * MiB;
constexpr size_t WS_TZY = 220 * MiB;
constexpr size_t WS_WE = 228 * MiB;
constexpr size_t WS_END = 232 * MiB;
constexpr int CW_BAR = 4096;

constexpr int RING_BYTES = 131072, S5_LDS_BYTES = 2 * 128 * 528, LDSCTL_OFF = S5_LDS_BYTES, MISC_OFF = LDSCTL_OFF + 320, LDS_BYTES = 147456;
static_assert(S5_LDS_BYTES >= RING_BYTES && MISC_OFF + 128 <= LDS_BYTES, "LDS map");

#define GAS __attribute__((address_space(1)))
#define LAS __attribute__((address_space(3)))
typedef unsigned short bf16;
typedef unsigned v4u __attribute__((ext_vector_type(4)));
typedef float f32x4 __attribute__((ext_vector_type(4)));
typedef float f32x2 __attribute__((ext_vector_type(2)));
typedef short bf16x8 __attribute__((ext_vector_type(8)));
#define LDS_WAIT() asm volatile("s_waitcnt lgkmcnt(0)" ::: "memory")
typedef __bf16 bf16x2_t __attribute__((ext_vector_type(2)));
__device__ __forceinline__ unsigned pk2(float lo, float hi) { unsigned r; asm("v_cvt_pk_bf16_f32 %0, %1, %2" : "=v"(r) : "v"(lo), "v"(hi)); return r; }
__device__ __forceinline__ unsigned f2bf(float f) { return pk2(f, f) & 0xffffu; }
__device__ __forceinline__ unsigned pk2c(float lo, float hi) { const f32x2 v = {lo, hi}; const bf16x2_t b = __builtin_convertvector(v, bf16x2_t); return __builtin_bit_cast(unsigned, b); }
__device__ __forceinline__ float bf2f(unsigned short b) { return __uint_as_float((unsigned)b << 16); }
__device__ __forceinline__ float bflo(unsigned w) { return __uint_as_float(w << 16); }
__device__ __forceinline__ float bfhi(unsigned w) { return __uint_as_float(w & 0xffff0000u); }

#define XB_TMO      128
#define XB_XCNT(j)  (256  + 64 * (j))
#define XB_XSUB(j)  (1280 + 64 * (j))
#define XB_XGEN(j)  (2304 + 64 * (j))
#define XB_TOP      3328
#define XB_TOPGEN   3392
#define XCD_BAR_WORDS 3456
#define XB_SPIN_CAP (1u << 18)
__device__ __forceinline__ unsigned xb_ld(unsigned* p)              { return __hip_atomic_load(p, __ATOMIC_RELAXED, __HIP_MEMORY_SCOPE_AGENT); }
__device__ __forceinline__ unsigned xb_add(unsigned* p, unsigned v) { return __hip_atomic_fetch_add(p, v, __ATOMIC_RELAXED, __HIP_MEMORY_SCOPE_AGENT); }
__device__ __forceinline__ unsigned xb_xcc_id() { return (unsigned)__builtin_amdgcn_s_getreg((3 << 11) | 20) & 0xFu; }
#define XB_SPIN(cond, bar) do { unsigned _sp = 0; while (cond) { __builtin_amdgcn_s_sleep(1); \
    if ((++_sp & 255u) == 0u) { if (xb_ld(&(bar)[XB_TMO])) break; if (_sp > XB_SPIN_CAP) { atomicAdd(&(bar)[XB_TMO], 1u); break; } } } } while (0)
struct XcdBarrier { unsigned* bar; unsigned x; volatile LAS unsigned* st; };
__device__ __forceinline__ XcdBarrier xcd_barrier_post(unsigned* bar, volatile LAS unsigned* st) {
    XcdBarrier b; b.bar = bar; b.x = xb_xcc_id(); b.st = st;
    if (threadIdx.x == 0) (void)xb_add(&bar[XB_XCNT(b.x)], 1u);
    return b;
}
__device__ __forceinline__ void xcd_barrier_complete(unsigned* bar, unsigned x, unsigned& nloc, unsigned& nx) {
    const unsigned G = gridDim.x * gridDim.y * gridDim.z;
    unsigned sum, cnt, mine, sp = 0u;
    for (;;) {
        sum = 0u; cnt = 0u; mine = 0u;
#pragma unroll
        for (unsigned j = 0; j < 16; ++j) { const unsigned c = xb_ld(&bar[XB_XCNT(j)]); sum += c; cnt += (c > 0u) ? 1u : 0u; mine = (j == x) ? c : mine; }
        if (sum == G) break;
        __builtin_amdgcn_s_sleep(1);
        if ((++sp & 255u) == 0u) { if (xb_ld(&bar[XB_TMO])) break; if (sp > XB_SPIN_CAP) { atomicAdd(&bar[XB_TMO], 1u); break; } }
    }
    nloc = mine > 0u ? mine : 1u; nx = cnt > 0u ? cnt : 1u;
}
__device__ __forceinline__ void xcd_barrier(const XcdBarrier& b) {
    asm volatile("s_waitcnt vmcnt(0)" ::: "memory");
    __syncthreads();
    if (threadIdx.x == 0) {
        unsigned* bar = b.bar;
        __builtin_amdgcn_s_waitcnt(0);
        unsigned nloc = b.st[0], nx = b.st[1];
        if (nloc == 0u) { xcd_barrier_complete(bar, b.x, nloc, nx); b.st[0] = nloc; b.st[1] = nx; }
        const unsigned old = xb_add(&bar[XB_XSUB(b.x)], 1u);
        const unsigned gen = old / nloc;
        if (old + 1u == (gen + 1u) * nloc) {
            __builtin_amdgcn_fence(__ATOMIC_RELEASE, "agent");
            asm volatile("s_waitcnt vmcnt(0)" ::: "memory");
            const unsigned og = xb_add(&bar[XB_TOP], 1u);
            const unsigned tg = og / nx;
            if (og + 1u == (tg + 1u) * nx) xb_add(&bar[XB_TOPGEN], 1u);
            else XB_SPIN(xb_ld(&bar[XB_TOPGEN]) == tg, bar);
            __builtin_amdgcn_fence(__ATOMIC_ACQUIRE, "agent");
            xb_add(&bar[XB_XGEN(b.x)], 1u);
            asm volatile("s_waitcnt vmcnt(0)" ::: "memory");
        } else {
            XB_SPIN(xb_ld(&bar[XB_XGEN(b.x)]) == gen, bar);
            __builtin_amdgcn_fence(__ATOMIC_ACQUIRE, "agent");
            asm volatile("s_waitcnt vmcnt(0)" ::: "memory");
        }
    }
    __syncthreads();
}

__device__ __forceinline__ float wave_sum(float v) {
#pragma unroll
    for (int o = 1; o < 64; o <<= 1) v += __shfl_xor(v, o);
    return v;
}
__device__ __forceinline__ float sum16(float v) {
    v += __shfl_xor(v, 1); v += __shfl_xor(v, 2); v += __shfl_xor(v, 4); v += __shfl_xor(v, 8); return v;
}
__device__ __forceinline__ float siluf(float v) { return v / (1.f + __expf(-v)); }
__device__ __forceinline__ float gelu_tanh(float x) {
    const float z = 0.7978845608028654f * (x + 0.044715f * x * x * x);
    const float t = 1.f - 2.f / (__expf(2.f * z) + 1.f);
    return 0.5f * x * (1.f + t);
}
__device__ __forceinline__ float log2_sigmoid(float x) { return -log1pf(expf(-x)) * LOG2E; }
__device__ __forceinline__ bf16x8 zero8() { return (bf16x8){0, 0, 0, 0, 0, 0, 0, 0}; }

__device__ __forceinline__ void p0_transpose_item(const float* W, int K, int N, bf16* WT, LAS float* scr, int item, int lane, int s0, int s1, float s) {
    const int nblk = N / 32, kb = item / nblk, nb = item % nblk, k0 = 64 * kb, n0 = 32 * nb;
    const float mul = (n0 >= s0 && n0 < s1) ? s : 1.f;
#pragma unroll 8
    for (int i = 0; i < 32; ++i) { const int kk = 2 * i + (lane >> 5); scr[kk * 33 + (lane & 31)] = W[(size_t)(k0 + kk) * N + n0 + (lane & 31)] * mul; }
    LDS_WAIT(); asm volatile("" ::: "memory");
    const int c = lane & 7;
#pragma unroll
    for (int j = 0; j < 4; ++j) { const int n = (lane >> 3) + 8 * j; const LAS float* sp = scr + (8 * c) * 33 + n;
        v4u o; o.x = pk2(sp[0 * 33], sp[1 * 33]); o.y = pk2(sp[2 * 33], sp[3 * 33]); o.z = pk2(sp[4 * 33], sp[5 * 33]); o.w = pk2(sp[6 * 33], sp[7 * 33]);
        *(GAS v4u*)(WT + (size_t)(n0 + n) * K + k0 + 8 * c) = o; }
    LDS_WAIT(); asm volatile("" ::: "memory");
}
__device__ __forceinline__ void p0_mod_item(LAS unsigned char* lds, int item, int tid, const float* c_ctx, const float* c, const float* w_ada, const float* b_ada, float* mod) {
    LAS float* sc = (LAS float*)lds; LAS float* red = (LAS float*)(lds + 20480);
    for (int i = tid; i < 5 * 1024; i += 512) { const int ci = i >> 10, k = i & 1023; const float v = (ci == 0) ? c_ctx[k] : c[(ci - 1) * 1024 + k]; sc[i] = siluf(v); }
    __syncthreads();
    const int col = tid & 31, kg = tid >> 5, n0 = item * 32;
    float acc[5] = {0.f, 0.f, 0.f, 0.f, 0.f};
#pragma unroll 16
    for (int kk = 0; kk < 64; ++kk) { const int k = kg * 64 + kk; const float w = w_ada[(size_t)k * 6144 + n0 + col];
#pragma unroll
        for (int ci = 0; ci < 5; ++ci) acc[ci] += sc[ci * 1024 + k] * w; }
#pragma unroll
    for (int ci = 0; ci < 5; ++ci) red[(kg * 5 + ci) * 32 + col] = acc[ci];
    __syncthreads();
    if (tid < 160) { const int ci = tid >> 5, c2 = tid & 31; float s = b_ada[n0 + c2];
#pragma unroll
        for (int g = 0; g < 16; ++g) s += red[(g * 5 + ci) * 32 + c2];
        mod[ci * 6144 + n0 + c2] = s; }
    __syncthreads();
}
__device__ __forceinline__ void p0_s5tab_item(LAS unsigned char* lds, int g, int dir, int tid, const float* a_re, const float* a_im, const float* log_dt, const float* b_re, const float* b_im,
                                              const float* c_re, const float* c_im, const float* dskip, f32x2* a16, bf16* tzy, bf16* we) {
    LAS f32x2* Cc = (LAS f32x2*)lds;
    LAS f32x2* BB = (LAS f32x2*)(lds + 8192);
    LAS f32x2* PW = (LAS f32x2*)(lds + 24576);
    LAS float* KK = (LAS float*)(lds + 33280);
    LAS float* K0 = (LAS float*)(lds + 54016);
    LAS float* DS = (LAS float*)(lds + 55296);
    if (tid < 128) {
        const int od = tid >> 6, d = od ? 1 - dir : dir, p = tid & 63, idx = (d * 32 + g) * 64 + p;
        const double are = (double)a_re[idx], aim = (double)a_im[idx], dt = exp((double)log_dt[d * 32 + g]);
        const double x = are * dt, y = aim * dt, ex = exp(x), br = ex * cos(y), bi = ex * sin(y);
        if (od == 0) { double pr = 1.0, pi = 0.0;
            for (int l = 0; l <= 16; ++l) { PW[l * 64 + p] = (f32x2){(float)pr, (float)pi}; const double nr = pr * br - pi * bi, ni = pr * bi + pi * br; pr = nr; pi = ni; }
            a16[idx] = PW[16 * 64 + p]; }
        const double nr = br - 1.0, ni = bi, den = are * are + aim * aim;
        const float cr = (float)((nr * are + ni * aim) / den), cim = (float)((ni * are - nr * aim) / den);
        const float* pre = b_re + (g * 64 + p) * 16; const float* pim = b_im + (g * 64 + p) * 16;
#pragma unroll
        for (int c = 0; c < 16; ++c) { const float r = pre[c], i = pim[c]; BB[(od * 64 + p) * 16 + c] = (f32x2){cr * r - cim * i, cr * i + cim * r}; }
    }
    for (int i = tid; i < 1024; i += 512) Cc[i] = (f32x2){c_re[g * 1024 + i], c_im[g * 1024 + i]};
    if (tid >= 128 && tid < 144) DS[tid - 128] = dskip[g * 16 + tid - 128];
    __syncthreads();
    {
        const int l = tid >> 5, c = (tid >> 1) & 15, hf = tid & 1;
        float acc[8];
#pragma unroll
        for (int e = 0; e < 8; ++e) acc[e] = 0.f;
        for (int p = 0; p < 64; ++p) { const f32x2 cc = Cc[c * 64 + p], pw = PW[l * 64 + p];
            const float gr = cc.x * pw.x - cc.y * pw.y, gi = cc.x * pw.y + cc.y * pw.x;
#pragma unroll
            for (int e = 0; e < 8; ++e) { const f32x2 bb = BB[p * 16 + 8 * hf + e]; acc[e] += gr * bb.x - gi * bb.y; } }
#pragma unroll
        for (int e = 0; e < 8; ++e) KK[l * 324 + c * 20 + 8 * hf + e] = acc[e];
        if (l == 0) {
#pragma unroll
            for (int e = 0; e < 8; ++e) acc[e] = 0.f;
            for (int p = 0; p < 64; ++p) { const f32x2 cc = Cc[c * 64 + p];
#pragma unroll
                for (int e = 0; e < 8; ++e) { const f32x2 bb = BB[(64 + p) * 16 + 8 * hf + e]; acc[e] += cc.x * bb.x - cc.y * bb.y; } }
#pragma unroll
            for (int e = 0; e < 8; ++e) K0[c * 20 + 8 * hf + e] = acc[e];
        }
    }
    __syncthreads();
    bf16* tz = tzy + (size_t)g * 256 * 512; bf16* wo = we + (size_t)g * 256 * 256;
    for (int q = tid; q < 4096; q += 512) {
        const int m = q & 15, n = q >> 4, t = n >> 4, c = n & 15;
        const bool mine = dir ? (m > t) : (m <= t);
        if (mine) {
            const int l = dir ? m - t : t - m;
            f32x4 v[4];
#pragma unroll
            for (int e = 0; e < 4; ++e) v[e] = *(const LAS f32x4*)(KK + l * 324 + c * 20 + 4 * e);
            if (m == t) {
#pragma unroll
                for (int e = 0; e < 4; ++e) v[e] = v[e] + *(const LAS f32x4*)(K0 + c * 20 + 4 * e);
                const float dsk = DS[c];
#pragma unroll
                for (int e = 0; e < 4; ++e) { if (c == 4 * e) v[e].x += dsk; if (c == 4 * e + 1) v[e].y += dsk; if (c == 4 * e + 2) v[e].z += dsk; if (c == 4 * e + 3) v[e].w += dsk; } }
            v4u w0, w1; w0.x = pk2(v[0].x, v[0].y); w0.y = pk2(v[0].z, v[0].w); w0.z = pk2(v[1].x, v[1].y); w0.w = pk2(v[1].z, v[1].w);
            w1.x = pk2(v[2].x, v[2].y); w1.y = pk2(v[2].z, v[2].w); w1.z = pk2(v[3].x, v[3].y); w1.w = pk2(v[3].z, v[3].w);
            *(GAS v4u*)(tz + (size_t)n * 512 + 16 * m) = w0; *(GAS v4u*)(tz + (size_t)n * 512 + 16 * m + 8) = w1;
        }
    }
    for (int v = tid; v < 256 * 16; v += 512) {
        const int n = v >> 4, j0 = (v & 15) * 8, t = n >> 4, c = n & 15, im = j0 >> 6, p0 = j0 & 63, l = dir ? 16 - t : t + 1; float o[8];
#pragma unroll
        for (int e = 0; e < 8; ++e) { const f32x2 cc = Cc[c * 64 + p0 + e], pw = PW[l * 64 + p0 + e];
            o[e] = im ? -(cc.x * pw.y + cc.y * pw.x) : (cc.x * pw.x - cc.y * pw.y); }
        v4u w; w.x = pk2(o[0], o[1]); w.y = pk2(o[2], o[3]); w.z = pk2(o[4], o[5]); w.w = pk2(o[6], o[7]);
        *(GAS v4u*)(tz + (size_t)n * 512 + 256 + 128 * dir + j0) = w;
    }
    for (int v = tid; v < 128 * 32; v += 512) {
        const int nn = v >> 5, k0 = (v & 31) * 8, im = nn >> 6, p = nn & 63, m = k0 >> 4, c0 = k0 & 15, l = dir ? m : 15 - m; float o[8];
        const f32x2 pw = PW[l * 64 + p];
#pragma unroll
        for (int e = 0; e < 8; ++e) { const f32x2 bb = BB[p * 16 + c0 + e]; o[e] = im ? (pw.x * bb.y + pw.y * bb.x) : (pw.x * bb.x - pw.y * bb.y); }
        v4u w; w.x = pk2(o[0], o[1]); w.y = pk2(o[2], o[3]); w.z = pk2(o[4], o[5]); w.w = pk2(o[6], o[7]);
        *(GAS v4u*)(wo + (size_t)(128 * dir + nn) * 256 + k0) = w;
    }
    __syncthreads();
}

__device__ __forceinline__ void row_load(const float* xrow, int lane, f32x4 (&v)[4]) {
    const GAS f32x4* xr = (const GAS f32x4*)xrow + lane;
#pragma unroll
    for (int j = 0; j < 4; ++j) v[j] = xr[64 * j];
}
__device__ __forceinline__ void row_norm(f32x4 (&v)[4]) {
    float s = 0.f;
#pragma unroll
    for (int j = 0; j < 4; ++j) s += (v[j].x + v[j].y) + (v[j].z + v[j].w);
    const float mean = wave_sum(s) * (1.f / D); float s2 = 0.f;
#pragma unroll
    for (int j = 0; j < 4; ++j) { v[j] = v[j] - mean; s2 += (v[j].x * v[j].x + v[j].y * v[j].y) + (v[j].z * v[j].z + v[j].w * v[j].w); }
    const float rstd = 1.f / sqrtf(wave_sum(s2) * (1.f / D) + LN_EPS);
#pragma unroll
    for (int j = 0; j < 4; ++j) v[j] = v[j] * rstd;
}
__device__ __forceinline__ void row_mod_store(const f32x4 (&v)[4], const float* sh, const float* scl, bf16* orow, int lane) {
    GAS unsigned long long* o8 = (GAS unsigned long long*)orow + lane;
#pragma unroll
    for (int j = 0; j < 4; ++j) { const f32x4 a = *((const GAS f32x4*)sh + lane + 64 * j), b = *((const GAS f32x4*)scl + lane + 64 * j);
        const f32x4 r = v[j] * (b + 1.f) + a;
        o8[64 * j] = (unsigned long long)pk2(r.x, r.y) | ((unsigned long long)pk2(r.z, r.w) << 32); }
}
__device__ __forceinline__ int cond_of_row(int m) { return m < NCTX ? 0 : 1 + ((m - NCTX) >> 11); }

struct RetUnit { int b, h, sc, row0, lu; bool ctx; };
__device__ __forceinline__ RetUnit ret_unit(int u) {
    RetUnit r; r.ctx = u < 64;
    if (r.ctx) { r.b = u >> 2; r.h = u & 3; r.sc = 0; r.row0 = r.b * 256; r.lu = 0; }
    else { const int lu = u - 64; r.lu = lu; r.b = lu >> 5; r.h = (lu >> 3) & 3; r.sc = lu & 7; r.row0 = NCTX + r.b * 2048 + r.sc * 256; }
    return r;
}
#define MFMA16(a, b, c) __builtin_amdgcn_mfma_f32_16x16x32_bf16((a), (b), (c), 0, 0, 0)

__device__ __forceinline__ void ret_states_unit(LAS unsigned char* lds, int u, int tid, const bf16* proj, const float* ret_decay, bf16* kvws, float* out_state) {
    const int lane = tid & 63, w = __builtin_amdgcn_readfirstlane(tid >> 6), fr = lane & 15, fq = lane >> 4;
    const RetUnit U = ret_unit(u);
    const float lgf = log2_sigmoid(ret_decay[U.h]), lgb = log2_sigmoid(ret_decay[4 + U.h]);
    LAS bf16* Vt = (LAS bf16*)lds; LAS bf16* Kft = (LAS bf16*)(lds + 18432); LAS bf16* Kbt = (LAS bf16*)(lds + 36864);
    f32x4 acc[2][8];
#pragma unroll
    for (int a = 0; a < 2; ++a)
#pragma unroll
        for (int c = 0; c < 8; ++c) acc[a][c] = (f32x4){0.f, 0.f, 0.f, 0.f};
    const int dir = w >> 2, dkb = (w & 3) * 32;
    v4u kreg[2], vreg[2];
#define R1_LOAD(sl) do { _Pragma("unroll") for (int i = 0; i < 2; ++i) { const int idx = tid + 512 * i, tt = idx & 63, ch = idx >> 6; \
        const bf16* rp = proj + (size_t)(U.row0 + 64 * (sl) + tt) * INC + U.h * 128 + ch * 8; kreg[i] = *(const GAS v4u*)(rp + 512); vreg[i] = *(const GAS v4u*)(rp + 1024); } } while (0)
    R1_LOAD(0);
    for (int sl = 0; sl < 4; ++sl) {
        __syncthreads();
#pragma unroll
        for (int i = 0; i < 2; ++i) { const int idx = tid + 512 * i, tt = idx & 63, ch = idx >> 6, tl = 64 * sl + tt;
            const float wf = __builtin_amdgcn_exp2f((float)(255 - tl) * lgf), wb = __builtin_amdgcn_exp2f((float)tl * lgb);
            const unsigned kw[4] = {kreg[i].x, kreg[i].y, kreg[i].z, kreg[i].w}, vw[4] = {vreg[i].x, vreg[i].y, vreg[i].z, vreg[i].w};
#pragma unroll
            for (int e = 0; e < 4; ++e) { const int r0 = (ch * 8 + 2 * e) * 72 + tt, r1 = r0 + 72;
                Vt[r0] = (bf16)(vw[e] & 0xffffu); Vt[r1] = (bf16)(vw[e] >> 16);
                const float k0 = bflo(kw[e]), k1 = bfhi(kw[e]);
                Kft[r0] = (bf16)f2bf(k0 * wf); Kft[r1] = (bf16)f2bf(k1 * wf); Kbt[r0] = (bf16)f2bf(k0 * wb); Kbt[r1] = (bf16)f2bf(k1 * wb); } }
        __syncthreads();
        if (sl < 3) R1_LOAD(sl + 1);
        const LAS bf16* Kt = dir ? Kbt : Kft;
        bf16x8 af[2][2];
#pragma unroll
        for (int rb = 0; rb < 2; ++rb)
#pragma unroll
            for (int ks = 0; ks < 2; ++ks) af[rb][ks] = *(const LAS bf16x8*)(Kt + (dkb + 16 * rb + fr) * 72 + 32 * ks + 8 * fq);
#pragma unroll
        for (int cb = 0; cb < 8; ++cb)
#pragma unroll
            for (int ks = 0; ks < 2; ++ks) { const bf16x8 bfr = *(const LAS bf16x8*)(Vt + (16 * cb + fr) * 72 + 32 * ks + 8 * fq);
#pragma unroll
                for (int rb = 0; rb < 2; ++rb) acc[rb][cb] = MFMA16(af[rb][ks], bfr, acc[rb][cb]); }
    }
#undef R1_LOAD
    if (U.ctx) { float* o = out_state + (size_t)((U.b * 2 + dir) * 4 + U.h) * 16384;
#pragma unroll
        for (int rb = 0; rb < 2; ++rb)
#pragma unroll
            for (int cb = 0; cb < 8; ++cb)
#pragma unroll
                for (int r = 0; r < 4; ++r) o[(dkb + 16 * rb + 4 * fq + r) * 128 + 16 * cb + fr] = acc[rb][cb][r]; }
    else { bf16* o = kvws + ((size_t)U.lu * 2 + dir) * 16384;
#pragma unroll
        for (int rb = 0; rb < 2; ++rb)
#pragma unroll
            for (int cb = 0; cb < 8; ++cb) { const unsigned long long pk = (unsigned long long)pk2c(acc[rb][cb][0], acc[rb][cb][1]) | ((unsigned long long)pk2c(acc[rb][cb][2], acc[rb][cb][3]) << 32);
                *(GAS unsigned long long*)(o + (16 * cb + fr) * 128 + dkb + 16 * rb + 4 * fq) = pk; } }
}

__device__ __forceinline__ bf16x8 scale8(bf16x8 q, float s) {
    const v4u u = __builtin_bit_cast(v4u, q); v4u r;
    r.x = pk2(bflo(u.x) * s, bfhi(u.x) * s); r.y = pk2(bflo(u.y) * s, bfhi(u.y) * s); r.z = pk2(bflo(u.z) * s, bfhi(u.z) * s); r.w = pk2(bflo(u.w) * s, bfhi(u.w) * s);
    return __builtin_bit_cast(bf16x8, r);
}
__device__ __forceinline__ void ret_out_unit(LAS unsigned char* lds, int u, int tid, const bf16* proj, const float* ret_decay, const bf16* kvws, const float* state_ret, bf16* mix) {
    const int lane = tid & 63, w = __builtin_amdgcn_readfirstlane(tid >> 6), fr = lane & 15, fq = lane >> 4;
    const RetUnit U = ret_unit(u);
    const float lgf = log2_sigmoid(ret_decay[U.h]), lgb = log2_sigmoid(ret_decay[4 + U.h]);
    LAS bf16* Ks = (LAS bf16*)lds;
    LAS bf16* Vt = (LAS bf16*)(lds + 17408);
    LAS bf16* Ps = (LAS bf16*)(lds + 35840 + w * 4608);
    bf16x8 qf[2][4];
#pragma unroll
    for (int rb = 0; rb < 2; ++rb)
#pragma unroll
        for (int ks = 0; ks < 4; ++ks) qf[rb][ks] = *(const GAS bf16x8*)(proj + (size_t)(U.row0 + 32 * w + 16 * rb + fr) * INC + U.h * 128 + 32 * ks + 8 * fq);
    f32x4 o[2][8];
#pragma unroll
    for (int a = 0; a < 2; ++a)
#pragma unroll
        for (int c = 0; c < 8; ++c) o[a][c] = (f32x4){0.f, 0.f, 0.f, 0.f};
    v4u kreg[2], vreg[2];
#define R2_LOAD(j) do { _Pragma("unroll") for (int i = 0; i < 2; ++i) { const int idx = tid + 512 * i; \
        kreg[i] = *(const GAS v4u*)(proj + (size_t)(U.row0 + 64 * (j) + (idx >> 4)) * INC + 512 + U.h * 128 + (idx & 15) * 8); \
        vreg[i] = *(const GAS v4u*)(proj + (size_t)(U.row0 + 64 * (j) + (idx & 63)) * INC + 1024 + U.h * 128 + (idx >> 6) * 8); } } while (0)
    R2_LOAD(0);
    for (int j = 0; j < 4; ++j) {
        __syncthreads();
#pragma unroll
        for (int i = 0; i < 2; ++i) { const int idx = tid + 512 * i;
            *(LAS v4u*)(Ks + (idx >> 4) * 136 + (idx & 15) * 8) = kreg[i];
            { const int tt = idx & 63, ch = idx >> 6; const unsigned vw[4] = {vreg[i].x, vreg[i].y, vreg[i].z, vreg[i].w};
#pragma unroll
              for (int e = 0; e < 4; ++e) { Vt[(ch * 8 + 2 * e) * 72 + tt] = (bf16)(vw[e] & 0xffffu); Vt[(ch * 8 + 2 * e + 1) * 72 + tt] = (bf16)(vw[e] >> 16); } } }
        __syncthreads();
        if (j < 3) R2_LOAD(j + 1);
#pragma unroll
        for (int cb = 0; cb < 4; ++cb) {
            bf16x8 kf[4];
#pragma unroll
            for (int ks = 0; ks < 4; ++ks) kf[ks] = *(const LAS bf16x8*)(Ks + (16 * cb + fr) * 136 + 32 * ks + 8 * fq);
#pragma unroll
            for (int rb = 0; rb < 2; ++rb) { f32x4 sc4 = (f32x4){0.f, 0.f, 0.f, 0.f};
#pragma unroll
                for (int ks = 0; ks < 4; ++ks) sc4 = MFMA16(qf[rb][ks], kf[ks], sc4);
#pragma unroll
                for (int r = 0; r < 4; ++r) { const int d = (32 * w + 16 * rb + 4 * fq + r) - (64 * j + 16 * cb + fr);
                    const float dec = d > 0 ? __builtin_amdgcn_exp2f((float)d * lgf) : (d < 0 ? __builtin_amdgcn_exp2f((float)(-d) * lgb) : 2.f);
                    Ps[(16 * rb + 4 * fq + r) * 72 + 16 * cb + fr] = (bf16)f2bf(sc4[r] * dec); } } }
        LDS_WAIT();
        bf16x8 pf[2][2];
#pragma unroll
        for (int rb = 0; rb < 2; ++rb)
#pragma unroll
            for (int ks = 0; ks < 2; ++ks) pf[rb][ks] = *(const LAS bf16x8*)(Ps + (16 * rb + fr) * 72 + 32 * ks + 8 * fq);
#pragma unroll
        for (int cb = 0; cb < 8; ++cb)
#pragma unroll
            for (int ks = 0; ks < 2; ++ks) { const bf16x8 vf = *(const LAS bf16x8*)(Vt + (16 * cb + fr) * 72 + 32 * ks + 8 * fq);
#pragma unroll
                for (int rb = 0; rb < 2; ++rb) o[rb][cb] = MFMA16(pf[rb][ks], vf, o[rb][cb]); }
    }
#undef R2_LOAD
    if (!U.ctx) {
        for (int dir = 0; dir < 2; ++dir) {
            const float lg = dir ? lgb : lgf;
            float rs[2];
#pragma unroll
            for (int rb = 0; rb < 2; ++rb) { const int i = 32 * w + 16 * rb + fr; rs[rb] = __builtin_amdgcn_exp2f((float)(dir ? (256 - i) : (i + 1)) * lg); }
            for (int s2 = 0; s2 < 2; ++s2) {
                __syncthreads();
                { const int dv = tid >> 2, q4 = tid & 3;
                  const int lub = U.lu & ~7;
                  const float wgt0 = __builtin_amdgcn_exp2f(256.f * (float)(dir ? (7 - U.sc) : U.sc) * lg);
                  const float* s0p = state_ret + (size_t)((U.b * 2 + dir) * 4 + U.h) * 16384 + dv;
#pragma unroll
                  for (int hh = 0; hh < 2; ++hh) {
                      const int dk0 = 64 * s2 + 16 * q4 + 8 * hh;
                      float a[8];
#pragma unroll
                      for (int e = 0; e < 8; ++e) a[e] = wgt0 * s0p[(dk0 + e) * 128];
#pragma unroll
                      for (int s = 0; s < 8; ++s) { const bool use = dir ? (s > U.sc) : (s < U.sc);
                          const float wgt = use ? __builtin_amdgcn_exp2f(256.f * (float)(dir ? (s - U.sc - 1) : (U.sc - 1 - s)) * lg) : 0.f;
                          const v4u t0 = *(const GAS v4u*)(kvws + ((size_t)(lub + s) * 2 + dir) * 16384 + dv * 128 + dk0);
                          a[0] += wgt * bflo(t0.x); a[1] += wgt * bfhi(t0.x); a[2] += wgt * bflo(t0.y); a[3] += wgt * bfhi(t0.y);
                          a[4] += wgt * bflo(t0.z); a[5] += wgt * bfhi(t0.z); a[6] += wgt * bflo(t0.w); a[7] += wgt * bfhi(t0.w); }
                      v4u w0; w0.x = pk2(a[0], a[1]); w0.y = pk2(a[2], a[3]); w0.z = pk2(a[4], a[5]); w0.w = pk2(a[6], a[7]);
                      *(LAS v4u*)(Vt + dv * 72 + 16 * q4 + 8 * hh) = w0; } }
                __syncthreads();
                bf16x8 qs[2][2];
#pragma unroll
                for (int rb = 0; rb < 2; ++rb) { qs[rb][0] = scale8(s2 ? qf[rb][2] : qf[rb][0], rs[rb]); qs[rb][1] = scale8(s2 ? qf[rb][3] : qf[rb][1], rs[rb]); }
#pragma unroll
                for (int cb = 0; cb < 8; ++cb)
#pragma unroll
                    for (int ks = 0; ks < 2; ++ks) { const bf16x8 vf = *(const LAS bf16x8*)(Vt + (16 * cb + fr) * 72 + 32 * ks + 8 * fq);
#pragma unroll
                        for (int rb = 0; rb < 2; ++rb) o[rb][cb] = MFMA16(qs[rb][ks], vf, o[rb][cb]); }
            }
        }
    }
    int lane2 = lane; asm volatile("" : "+v"(lane2));
    const int fr2 = lane2 & 15, fq2 = lane2 >> 4;
#pragma unroll
    for (int rb = 0; rb < 2; ++rb)
#pragma unroll
        for (int r = 0; r < 4; ++r) {
            float sm = 0.f;
#pragma unroll
            for (int cb = 0; cb < 8; ++cb) sm += o[rb][cb][r];
            const float mean = sum16(sm) * (1.f / 128.f); float q = 0.f;
#pragma unroll
            for (int cb = 0; cb < 8; ++cb) { const float d = o[rb][cb][r] - mean; q += d * d; }
            const float rstd = 1.f / sqrtf(sum16(q) * (1.f / 128.f) + LN_EPS);
            const size_t tok = (size_t)(U.row0 + 32 * w + 16 * rb + 4 * fq2 + r);
            const bf16* gp = proj + tok * INC + 1536 + U.h * 128 + fr2; bf16* mp = mix + tok * D + U.h * 128 + fr2;
#pragma unroll
            for (int cb = 0; cb < 8; ++cb) { const float g = bf2f(gp[16 * cb]); mp[16 * cb] = (bf16)f2bf((o[rb][cb][r] - mean) * rstd * siluf(g)); }
        }
}

struct S5Ptrs { const bf16* proj; const f32x2* a16; const bf16* tzy; const bf16* we; const float* s0_re; const float* s0_im; bf16* yg; float* out_re; float* out_im; };
__device__ __forceinline__ void s5_item(LAS unsigned char* lds, int it, int tid, const S5Ptrs& P) {
    const int lane = tid & 63, w = __builtin_amdgcn_readfirstlane(tid >> 6), fr = lane & 15, fq = lane >> 4;
    const int g = it / 6, j6 = it - 6 * g;
    const bool ctx = j6 < 2;
    const int tokbase = ctx ? j6 * 2048 : NCTX + (j6 - 2) * 2048;
    LAS unsigned char* UL = lds;
    LAS unsigned char* EL = lds + 67584;
    {
        const bf16* up = P.proj + (size_t)tokbase * INC + 2048 + g * 16;
        v4u t[8];
#pragma unroll
        for (int i = 0; i < 8; ++i) { const int pc = tid + 512 * i, tok = pc >> 1, hf = pc & 1; t[i] = *(const GAS v4u*)(up + (size_t)tok * INC + 8 * hf); }
#pragma unroll
        for (int i = 0; i < 8; ++i) { const int pc = tid + 512 * i, tok = pc >> 1, hf = pc & 1; *(LAS v4u*)(UL + (tok >> 4) * 528 + (tok & 15) * 32 + 16 * hf) = t[i]; }
    }
    __syncthreads();
#define S5_LDU(dst, rb) do { _Pragma("unroll") for (int ks = 0; ks < 8; ++ks) dst[ks] = *(const LAS bf16x8*)(UL + (16 * (rb) + fr) * 528 + (2 * ks + (fq >> 1)) * 32 + 16 * (fq & 1)); } while (0)
    {
        bf16x8 bE[2][8];
#pragma unroll
        for (int nb = 0; nb < 2; ++nb)
#pragma unroll
            for (int ks = 0; ks < 8; ++ks) bE[nb][ks] = *(const GAS bf16x8*)(P.we + ((size_t)g * 256 + 16 * (2 * w + nb) + fr) * 256 + 32 * ks + 8 * fq);
        for (int rb = 0; rb < 8; ++rb) {
            bf16x8 aU[8]; S5_LDU(aU, rb);
#pragma unroll
            for (int nb = 0; nb < 2; ++nb) { f32x4 acc = (f32x4){0.f, 0.f, 0.f, 0.f};
#pragma unroll
                for (int ks = 0; ks < 8; ++ks) acc = MFMA16(bE[nb][ks], aU[ks], acc);
                *(LAS unsigned long long*)(EL + (16 * rb + fr) * 528 + (16 * (2 * w + nb) + 4 * fq) * 2) = (unsigned long long)pk2c(acc[0], acc[1]) | ((unsigned long long)pk2c(acc[2], acc[3]) << 32); }
        }
    }
    __syncthreads();
    {
        const int nseq = ctx ? 8 : 1, cps = ctx ? 16 : 128;
        for (int q = w; q < 2 * nseq; q += NWAVES) {
            const int seq = q >> 1, dir = q & 1;
            const f32x2 A = P.a16[(dir * 32 + g) * 64 + lane];
            float sre = 0.f, sim = 0.f;
            if (!ctx) { const int si = (((j6 - 2) * 2 + dir) * 32 + g) * 64 + lane; sre = P.s0_re[si]; sim = P.s0_im[si]; }
            LAS bf16* base = (LAS bf16*)(EL + dir * 256) + lane;
            for (int i0 = 0; i0 < cps; i0 += 8) {
                float ere[8], eim[8];
#pragma unroll
                for (int i = 0; i < 8; ++i) { const int k = seq * cps + (dir ? cps - 1 - (i0 + i) : i0 + i); ere[i] = bf2f(base[k * 264]); eim[i] = bf2f(base[k * 264 + 64]); }
#pragma unroll
                for (int i = 0; i < 8; ++i) { const int k = seq * cps + (dir ? cps - 1 - (i0 + i) : i0 + i);
                    { const unsigned pk = pk2(sre, sim); base[k * 264] = (bf16)(pk & 0xffffu); base[k * 264 + 64] = (bf16)(pk >> 16); }
                    const float nr = A.x * sre - A.y * sim + ere[i], ni = A.x * sim + A.y * sre + eim[i]; sre = nr; sim = ni; }
            }
            if (ctx) { const int oi = (((j6 * 8 + seq) * 2 + dir) * 32 + g) * 64 + lane; P.out_re[oi] = sre; P.out_im[oi] = sim; }
        }
    }
    __syncthreads();
    {
        bf16x8 bT[2][16];
#pragma unroll
        for (int nb = 0; nb < 2; ++nb)
#pragma unroll
            for (int ks = 0; ks < 16; ++ks) bT[nb][ks] = *(const GAS bf16x8*)(P.tzy + ((size_t)g * 256 + 16 * (2 * w + nb) + fr) * 512 + 32 * ks + 8 * fq);
        for (int rb = 0; rb < 8; ++rb) {
            bf16x8 aU[8], aS[8]; S5_LDU(aU, rb);
#pragma unroll
            for (int ks = 0; ks < 8; ++ks) aS[ks] = *(const LAS bf16x8*)(EL + (16 * rb + fr) * 528 + (32 * ks + 8 * fq) * 2);
#pragma unroll
            for (int nb = 0; nb < 2; ++nb) { f32x4 acc = (f32x4){0.f, 0.f, 0.f, 0.f};
#pragma unroll
                for (int ks = 0; ks < 8; ++ks) acc = MFMA16(bT[nb][ks], aU[ks], acc);
#pragma unroll
                for (int ks = 0; ks < 8; ++ks) acc = MFMA16(bT[nb][8 + ks], aS[ks], acc);
                const size_t tok = (size_t)(tokbase + (16 * rb + fr) * 16 + 2 * w + nb);
                const unsigned long long pk = (unsigned long long)pk2(gelu_tanh(acc[0]), gelu_tanh(acc[1])) | ((unsigned long long)pk2(gelu_tanh(acc[2]), gelu_tanh(acc[3])) << 32);
                *(GAS unsigned long long*)(P.yg + tok * SW + g * 16 + 4 * fq) = pk; }
        }
    }
#undef S5_LDU
}

struct Args { const float* in[30]; float* out; unsigned char* ws; };
__global__ void __launch_bounds__(NWAVES * 64, 2) fwd_kernel(Args args) {
    extern __shared__ __attribute__((aligned(16))) unsigned char lds_raw[];
    LAS unsigned char* lds = (LAS unsigned char*)lds_raw;
    volatile LAS unsigned* MISC = (volatile LAS unsigned*)(lds + MISC_OFF);
    const int tid = threadIdx.x, lane = tid & 63, wave = __builtin_amdgcn_readfirstlane(tid >> 6);
    const int G = gridDim.x, bid = blockIdx.x;
    const int gw = bid * NWAVES + wave, NGW = G * NWAVES;
    unsigned char* ws = args.ws;
    for (int u = tid; u < (LDS_BYTES - LDSCTL_OFF) / 4; u += NWAVES * 64) ((LAS unsigned*)(lds + LDSCTL_OFF))[u] = 0u;
    __syncthreads();
    XcdBarrier bar = xcd_barrier_post((unsigned*)(ws + WS_CTL) + CW_BAR, MISC + 8);

    const float* x_prompt = args.in[0]; const float* x_sample = args.in[1]; const float* state_ret = args.in[2];
    const float* state_s5_re = args.in[3]; const float* state_s5_im = args.in[4]; const float* c_lat = args.in[5]; const float* c_ctx = args.in[6];
    const float* w_ada = args.in[7]; const float* b_ada = args.in[8]; const float* w_in = args.in[9]; const float* ret_decay = args.in[10];
    const float* s5_a_re = args.in[11]; const float* s5_a_im = args.in[12]; const float* s5_log_dt = args.in[13];
    const float* s5_b_re = args.in[14]; const float* s5_b_im = args.in[15]; const float* s5_c_re = args.in[16]; const float* s5_c_im = args.in[17];
    const float* s5_d = args.in[18]; const float* w_glu = args.in[19]; const float* b_glu = args.in[20]; const float* w_out = args.in[21];
    const float* ln1_g = args.in[22]; const float* ln1_b = args.in[23]; const float* w_ff1 = args.in[24]; const float* b_ff1 = args.in[25];
    const float* w_ff2 = args.in[26]; const float* b_ff2 = args.in[27]; const float* ln2_g = args.in[28]; const float* ln2_b = args.in[29];
    float* out = args.out;
    float* out_y = out;
    float* out_state = out + (size_t)NTOK * D;
    float* out_s5re = out_state + (size_t)16 * 2 * 4 * 128 * 128;
    float* out_s5im = out_s5re + 16 * 2 * 32 * 64;

    float* mod = (float*)(ws + WS_MOD);
    f32x2* a16tab = (f32x2*)(ws + WS_AT); bf16* TZY = (bf16*)(ws + WS_TZY); bf16* WE = (bf16*)(ws + WS_WE);
    bf16* WinT = (bf16*)(ws + WS_WIN); bf16* WgluT = (bf16*)(ws + WS_WGLU); bf16* WoutT = (bf16*)(ws + WS_WOUT); bf16* Wff1T = (bf16*)(ws + WS_WFF1); bf16* Wff2T = (bf16*)(ws + WS_WFF2);
    bf16* H = (bf16*)(ws + WS_H); float* X1 = (float*)(ws + WS_X1); bf16* PROJ = (bf16*)(ws + WS_PROJ); bf16* KV = (bf16*)(ws + WS_KV);
    bf16* MIX = (bf16*)(ws + WS_MIX); bf16* YG = (bf16*)(ws + WS_YG); bf16* FFH = (bf16*)(ws + WS_FFH);

    {
        if (bid < 192) p0_mod_item(lds, bid, tid, c_ctx, c_lat, w_ada, b_ada, mod);
        else p0_s5tab_item(lds, (bid - 192) >> 1, (bid - 192) & 1, tid, s5_a_re, s5_a_im, s5_log_dt, s5_b_re, s5_b_im, s5_c_re, s5_c_im, s5_d, a16tab, TZY, WE);
        __syncthreads();
        LAS float* scr = (LAS float*)(lds + wave * 16384);
        constexpr int I_IN = (D / 64) * (INC / 32), I_GLU = (SW / 64) * (SW / 32), I_OUT = (D / 64) * (D / 32), I_F1 = (D / 64) * (FF / 32), I_F2 = (FF / 64) * (D / 32);
        constexpr int NITEMS = I_IN + I_GLU + I_OUT + I_F1 + I_F2;
        if (bid < 192) for (int it = gw; it < NITEMS; it += 192 * NWAVES) {
            int r = it;
            if (r < I_IN) { p0_transpose_item(w_in, D, INC, WinT, scr, r, lane, 512, 1024, KSCALE); continue; } r -= I_IN;
            if (r < I_GLU) { p0_transpose_item(w_glu, SW, SW, WgluT, scr, r, lane, 0, 0, 1.f); continue; } r -= I_GLU;
            if (r < I_OUT) { p0_transpose_item(w_out, D, D, WoutT, scr, r, lane, 0, 0, 1.f); continue; } r -= I_OUT;
            if (r < I_F1) { p0_transpose_item(w_ff1, D, FF, Wff1T, scr, r, lane, 0, 0, 1.f); continue; } r -= I_F1;
            p0_transpose_item(w_ff2, FF, D, Wff2T, scr, r, lane, 0, 0, 1.f);
        }
    }
    xcd_barrier(bar);

    for (int m = gw; m < NTOK; m += NGW) {
        const float* xr = m < NCTX ? x_prompt + (size_t)m * D : x_sample + (size_t)(m - NCTX) * D;
        const float* mp = mod + cond_of_row(m) * 6144;
        f32x4 v[4]; row_load(xr, lane, v); row_norm(v); row_mod_store(v, mp, mp + 1024, H + (size_t)m * D, lane);
    }
    xcd_barrier(bar);

    {
        pg8::Gemm g{H, WinT, NTOK, INC, D}; pg8::StaticOrder S; S.init(NTOK, INC, G, bid);
        pg8::EpiBf16<0> Ep{PROJ, INC, nullptr, 0, 0, 1.f};
        pg8::gemm_phase<pg8::EpiBf16<0>, pg8::StaticOrder, PG8_ALIGN, PG8_SP2>(lds, g, S, Ep);
    }
    xcd_barrier(bar);

    S5Ptrs SP{PROJ, a16tab, TZY, WE, state_s5_re, state_s5_im, YG, out_s5re, out_s5im};
    if (bid < N_RET_UNITS) { int tidp = tid; asm volatile("" : "+v"(tidp));
        ret_states_unit(lds, bid, tidp, PROJ, ret_decay, KV, out_state);
        __syncthreads();
        s5_item(lds, bid, tidp, SP); }
    xcd_barrier(bar);

    if (bid < N_RET_UNITS) { int tidp = tid; asm volatile("" : "+v"(tidp)); ret_out_unit(lds, bid, tidp, PROJ, ret_decay, KV, state_ret, MIX); }
    {
        pg8::Gemm g{YG, WgluT, NTOK, SW, SW}; pg8::StaticOrder S; S.init(NTOK, SW, G - N_RET_UNITS, bid < N_RET_UNITS ? (1 << 20) : bid - N_RET_UNITS);
        pg8::EpiGlu Ep{YG, SW, MIX, D, 512, b_glu};
        pg8::gemm_phase<pg8::EpiGlu, pg8::StaticOrder, PG8_ALIGN, PG8_SP2>(lds, g, S, Ep);
    }
    xcd_barrier(bar);

    {
        pg8::Gemm g{MIX, WoutT, NTOK, D, D}; pg8::StaticOrder S; S.init(NTOK, D, G, bid);
        pg8::EpiRes Ep{x_prompt, x_sample, out_y, nullptr, mod, 2048, ALPHA};
        pg8::gemm_phase<pg8::EpiRes, pg8::StaticOrder, PG8_ALIGN, PG8_SP2>(lds, g, S, Ep);
    }
    xcd_barrier(bar);

    for (int m = gw; m < NTOK; m += NGW) {
        const float* mp = mod + cond_of_row(m) * 6144;
        f32x4 v[4]; row_load(out_y + (size_t)m * D, lane, v); row_norm(v);
        GAS f32x4* xo = (GAS f32x4*)(X1 + (size_t)m * D) + lane;
#pragma unroll
        for (int j = 0; j < 4; ++j) { v[j] = v[j] * *((const GAS f32x4*)ln1_g + lane + 64 * j) + *((const GAS f32x4*)ln1_b + lane + 64 * j); xo[64 * j] = v[j]; }
        row_norm(v); row_mod_store(v, mp + 3072, mp + 4096, H + (size_t)m * D, lane);
    }
    xcd_barrier(bar);

    {
        pg8::Gemm g{H, Wff1T, NTOK, FF, D}; pg8::StaticOrder S; S.init(NTOK, FF, G, bid);
        pg8::EpiSqRelu Ep{FFH, FF, b_ff1};
        pg8::gemm_phase<pg8::EpiSqRelu, pg8::StaticOrder, PG8_ALIGN, PG8_SP2>(lds, g, S, Ep);
    }
    xcd_barrier(bar);

    {
        pg8::Gemm g{FFH, Wff2T, NTOK, D, FF}; pg8::StaticOrder S; S.init(NTOK, D, G, bid);
        pg8::EpiRes Ep{X1, X1 + (size_t)NCTX * D, out_y, b_ff2, mod, 5120, ALPHA};
        pg8::gemm_phase<pg8::EpiRes, pg8::StaticOrder, PG8_ALIGN, PG8_SP2>(lds, g, S, Ep);
    }
    xcd_barrier(bar);

    for (int m = gw; m < NTOK; m += NGW) {
        f32x4 v[4]; row_load(out_y + (size_t)m * D, lane, v); row_norm(v);
        GAS f32x4* yo = (GAS f32x4*)(out_y + (size_t)m * D) + lane;
#pragma unroll
        for (int j = 0; j < 4; ++j) yo[64 * j] = v[j] * *((const GAS f32x4*)ln2_g + lane + 64 * j) + *((const GAS f32x4*)ln2_b + lane + 64 * j);
    }
}

extern "C" void kernel_launch(void* const* d_in, const int* in_sizes, int n_in, void* d_out, int out_size, void* d_ws, size_t ws_size, hipStream_t stream) {
    static int grid = 0;
    if (grid == 0) {
        if (n_in != 30 || ws_size < WS_END) { fprintf(stderr, "kernel_launch: built for 30 inputs and >= %zu bytes of workspace; got n_in %d, ws %zu; nothing launched\n", (size_t)WS_END, n_in, ws_size); grid = -1; return; }
        int dev = 0, cus = 0, per_cu = 0;
        if (hipGetDevice(&dev) != hipSuccess || hipDeviceGetAttribute(&cus, hipDeviceAttributeMultiprocessorCount, dev) != hipSuccess) { fprintf(stderr, "kernel_launch: device query failed\n"); grid = -1; return; }
        if (hipFuncSetAttribute((const void*)fwd_kernel, hipFuncAttributeMaxDynamicSharedMemorySize, LDS_BYTES) != hipSuccess) { fprintf(stderr, "kernel_launch: hipFuncSetAttribute failed\n"); grid = -1; return; }
        if (hipOccupancyMaxActiveBlocksPerMultiprocessor(&per_cu, (const void*)fwd_kernel, NWAVES * 64, LDS_BYTES) != hipSuccess || per_cu < 1) {
            fprintf(stderr, "kernel_launch: occupancy query reports %d workgroups per CU; nothing launched\n", per_cu); (void)hipGetLastError(); grid = -1; return; }
        if (cus != 256) { fprintf(stderr, "kernel_launch: built for a 256-CU device (got %d); nothing launched\n", cus); grid = -1; return; }
        grid = cus;
    }
    if (grid < 0) return;
    (void)hipMemsetAsync((char*)d_ws + WS_CTL, 0, CTL_ZERO_BYTES, stream);
    Args a{};
    for (int i = 0; i < 30; ++i) a.in[i] = (const float*)d_in[i];
    a.out = (float*)d_out; a.ws = (unsigned char*)d_ws;
    hipLaunchKernelGGL(fwd_kernel, dim3(grid), dim3(NWAVES * 64), LDS_BYTES, stream, a);
}
```

```cpp
#include <hip/hip_runtime.h>
#include <cstdio>
#include <cstdint>
namespace pg8 {
#define PG8_LAS __attribute__((address_space(3)))
typedef unsigned short bf16_t;
typedef short bf16x8 __attribute__((ext_vector_type(8)));
typedef float f32x4 __attribute__((ext_vector_type(4)));
typedef unsigned u32x4 __attribute__((ext_vector_type(4)));
constexpr int BM = 256, BK = 64, HALF = 128, HTB = HALF * BK * 2  , STAGE_BYTES = 8 * HTB, NXCD = 8, WGM = 8;

__host__ __device__ __forceinline__ int lds_byte(int r, int c) { const int st = (r >> 4) * 2 + (c >> 5), rr = r & 15, cc = c & 31, ob = rr * 64 + cc * 2; return st * 1024 + (ob ^ (((ob >> 9) & 1) << 5)); }
__host__ __device__ __forceinline__ void stage_rc(int b, int& R, int& C) { const int st = b / 1024, sb = b % 1024, swz = sb ^ (((sb >> 9) & 1) << 5); R = (st >> 1) * 16 + swz / 64; C = (st & 1) * 32 + (swz % 64) / 2; }
__host__ __device__ __forceinline__ int perm32(int rho) { const int n = rho >> 4, i = rho & 15; return 8 * (i >> 2) + 4 * n + (i & 3); }

struct Unit { int pm, pn; };
struct Gemm { const bf16_t* A; const bf16_t* Bt; int M, N, K; };

struct StaticOrder {
    int nM, nN, nwg, G, c;
    __host__ __device__ void init(int M, int N, int G_, int c_) { nM = M / BM; nN = N / BM; nwg = nM * nN; G = G_; c = c_; }
    __host__ __device__ bool next(int i, Unit& u) const {
        const long L = (long)i * G + c; if (L >= nwg) return false;
        int wgid = (int)L; { const int q = nwg / NXCD, r = nwg % NXCD, xcd = wgid % NXCD, off = wgid / NXCD; wgid = (xcd < r ? xcd * (q + 1) : r * (q + 1) + (xcd - r) * q) + off; }
        const int nig = WGM * nN, gid = wgid / nig, fm = gid * WGM, gsz = (nM - fm) < WGM ? (nM - fm) : WGM;
        u.pm = fm + ((wgid % nig) % gsz); u.pn = (wgid % nig) / gsz; return true;
    }
    __device__ __forceinline__ void a_ready(const Unit&) const {}
    __device__ __forceinline__ void done(const Unit&) const {}
};

__device__ __forceinline__ unsigned cvt_pk_bf16(float lo, float hi) { unsigned r; asm volatile("v_cvt_pk_bf16_f32 %0, %1, %2" : "=v"(r) : "v"(lo), "v"(hi)); return r; }
typedef float f32x2 __attribute__((ext_vector_type(2)));
__device__ __forceinline__ f32x2 gelu_pk(f32x2 v) {
    const f32x2 av = __builtin_elementwise_abs(v), d = av * 0.2316418882f + 1.0f;
    f32x2 t; t.x = __builtin_amdgcn_rcpf(d.x); t.y = __builtin_amdgcn_rcpf(d.y);
    f32x2 q = t * 0.5307027145f + (-0.7265760135f); q = q * t + 0.7107068705f; q = q * t + (-0.142248368f); q = q * t + 0.127414796f; q = q * t;
    const f32x2 s = (v * v) * (-0.72134752044f);
    f32x2 e; e.x = __builtin_amdgcn_exp2f(s.x); e.y = __builtin_amdgcn_exp2f(s.y);
    const f32x2 m = v * (q * e), r = v - m;
    f32x2 o; o.x = v.x < 0.f ? m.x : r.x; o.y = v.y < 0.f ? m.y : r.y; return o;
}

template <int ACT  > struct EpiBf16 {
    static constexpr bool PERM = true, AFTER_DRAIN = false; static_assert(ACT == 0 || ACT == 1, "EpiBf16: ACT is 0 (none) or 1 (gelu_pk)");
    bf16_t* O; int ldc; const float* bias; int split_cols; size_t split_stride; float scale0;
    __device__ __forceinline__ void operator()(const f32x4 (&acc)[2][2][4][2], const Unit& u, int wr, int wc, int fr, int fq) const {
        const int row0 = u.pm * BM + wr * 64 + fr; int colt = u.pn * BM; bf16_t* base = O;
        float sc = 1.f; if (split_cols) { const int t = colt / split_cols; base += (size_t)t * split_stride; colt -= t * split_cols; if (t == 0) sc = scale0; }
        const int col0 = colt + wc * 32 + 8 * fq, bcol0 = u.pn * BM + wc * 32 + 8 * fq;
        f32x4 bv[2][2];
#pragma unroll
        for (int bj = 0; bj < 2; ++bj)
#pragma unroll
            for (int n = 0; n < 2; ++n) bv[bj][n] = bias ? *(const f32x4*)(bias + bcol0 + bj * HALF + 4 * n) : (f32x4){0.f, 0.f, 0.f, 0.f};
#pragma unroll
        for (int ai = 0; ai < 2; ++ai)
#pragma unroll
            for (int m = 0; m < 4; ++m) { bf16_t* rowp = base + (size_t)(row0 + ai * HALF + m * 16) * ldc + col0;
#pragma unroll
                for (int bj = 0; bj < 2; ++bj) { f32x4 v0 = acc[ai][bj][m][0] + bv[bj][0], v1 = acc[ai][bj][m][1] + bv[bj][1];
                    if (ACT == 1) { f32x2 a = gelu_pk((f32x2){v0[0], v0[1]}), b = gelu_pk((f32x2){v0[2], v0[3]}), c = gelu_pk((f32x2){v1[0], v1[1]}), d = gelu_pk((f32x2){v1[2], v1[3]});
                        v0 = (f32x4){a.x, a.y, b.x, b.y}; v1 = (f32x4){c.x, c.y, d.x, d.y}; }
                    v0 = v0 * sc; v1 = v1 * sc; u32x4 w; w.x = cvt_pk_bf16(v0[0], v0[1]); w.y = cvt_pk_bf16(v0[2], v0[3]); w.z = cvt_pk_bf16(v1[0], v1[1]); w.w = cvt_pk_bf16(v1[2], v1[3]);
                    *(u32x4*)(rowp + bj * HALF) = w; } }
    }
};
struct EpiProj {
    static constexpr bool PERM = true, AFTER_DRAIN = false;
    bf16_t* O; int ldc; bf16_t* U; int M;
    __device__ __forceinline__ void operator()(const f32x4 (&acc)[2][2][4][2], const Unit& u, int wr, int wc, int fr, int fq) const {
        const int row0 = u.pm * BM + wr * 64 + fr; const int col0 = u.pn * BM + wc * 32 + 8 * fq;
#pragma unroll
        for (int ai = 0; ai < 2; ++ai)
#pragma unroll
            for (int m = 0; m < 4; ++m) { const int row = row0 + ai * HALF + m * 16;
#pragma unroll
                for (int bj = 0; bj < 2; ++bj) { const f32x4 v0 = acc[ai][bj][m][0] + 0.f, v1 = acc[ai][bj][m][1] + 0.f;
                    u32x4 w; w.x = cvt_pk_bf16(v0[0], v0[1]); w.y = cvt_pk_bf16(v0[2], v0[3]); w.z = cvt_pk_bf16(v1[0], v1[1]); w.w = cvt_pk_bf16(v1[2], v1[3]);
                    const int col = col0 + bj * HALF;
                    if (u.pn < 8) *(u32x4*)(O + (size_t)row * ldc + col) = w;
                    else { const int uc = col - 2048; *(u32x4*)(U + ((size_t)(uc >> 4) * M + row) * 16 + (uc & 8)) = w; } } }
    }
};

struct EpiSqRelu {
    static constexpr bool PERM = true, AFTER_DRAIN = false;
    bf16_t* O; int ldc; const float* bias;
    __device__ __forceinline__ void operator()(const f32x4 (&acc)[2][2][4][2], const Unit& u, int wr, int wc, int fr, int fq) const {
        const int row0 = u.pm * BM + wr * 64 + fr; const int col0 = u.pn * BM + wc * 32 + 8 * fq;
        f32x4 bv[2][2];
#pragma unroll
        for (int bj = 0; bj < 2; ++bj)
#pragma unroll
            for (int n = 0; n < 2; ++n) bv[bj][n] = *(const f32x4*)(bias + col0 + bj * HALF + 4 * n);
#pragma unroll
        for (int ai = 0; ai < 2; ++ai)
#pragma unroll
            for (int m = 0; m < 4; ++m) { bf16_t* rowp = O + (size_t)(row0 + ai * HALF + m * 16) * ldc + col0;
#pragma unroll
                for (int bj = 0; bj < 2; ++bj) { f32x4 v0 = acc[ai][bj][m][0] + bv[bj][0], v1 = acc[ai][bj][m][1] + bv[bj][1];
#pragma unroll
                    for (int e = 0; e < 4; ++e) { const float a = fmaxf(v0[e], 0.f), b = fmaxf(v1[e], 0.f); v0[e] = a * a; v1[e] = b * b; }
                    u32x4 w; w.x = cvt_pk_bf16(v0[0], v0[1]); w.y = cvt_pk_bf16(v0[2], v0[3]); w.z = cvt_pk_bf16(v1[0], v1[1]); w.w = cvt_pk_bf16(v1[2], v1[3]);
                    *(u32x4*)(rowp + bj * HALF) = w; } }
    }
};
struct EpiGlu {
    static constexpr bool PERM = true, AFTER_DRAIN = false;
    const bf16_t* Y; int ldy; bf16_t* O; int ldo; int ocol0; const float* bias;
    __device__ __forceinline__ void operator()(const f32x4 (&acc)[2][2][4][2], const Unit& u, int wr, int wc, int fr, int fq) const {
        const int row0 = u.pm * BM + wr * 64 + fr; const int col0 = u.pn * BM + wc * 32 + 8 * fq;
        f32x4 bv[2][2];
#pragma unroll
        for (int bj = 0; bj < 2; ++bj)
#pragma unroll
            for (int n = 0; n < 2; ++n) bv[bj][n] = *(const f32x4*)(bias + col0 + bj * HALF + 4 * n);
#pragma unroll
        for (int ai = 0; ai < 2; ++ai)
#pragma unroll
            for (int m = 0; m < 4; ++m) { const size_t row = (size_t)(row0 + ai * HALF + m * 16);
#pragma unroll
                for (int bj = 0; bj < 2; ++bj) { const f32x4 v0 = acc[ai][bj][m][0] + bv[bj][0], v1 = acc[ai][bj][m][1] + bv[bj][1];
                    const u32x4 yv = *(const u32x4*)(Y + row * ldy + col0 + bj * HALF);
                    float y[8]; y[0] = __uint_as_float(yv.x << 16); y[1] = __uint_as_float(yv.x & 0xffff0000u); y[2] = __uint_as_float(yv.y << 16); y[3] = __uint_as_float(yv.y & 0xffff0000u);
                    y[4] = __uint_as_float(yv.z << 16); y[5] = __uint_as_float(yv.z & 0xffff0000u); y[6] = __uint_as_float(yv.w << 16); y[7] = __uint_as_float(yv.w & 0xffff0000u);
                    float o[8];
#pragma unroll
                    for (int e = 0; e < 4; ++e) { o[e] = y[e] / (1.f + __expf(-v0[e])); o[4 + e] = y[4 + e] / (1.f + __expf(-v1[e])); }
                    u32x4 w; w.x = cvt_pk_bf16(o[0], o[1]); w.y = cvt_pk_bf16(o[2], o[3]); w.z = cvt_pk_bf16(o[4], o[5]); w.w = cvt_pk_bf16(o[6], o[7]);
                    *(u32x4*)(O + row * ldo + ocol0 + col0 + bj * HALF) = w; } }
    }
};
struct EpiRes {
    static constexpr bool PERM = false, AFTER_DRAIN = false;
    const float* xlo; const float* xhi; float* Z; const float* bias; const float* mod; int goff; float alpha;
    __device__ __forceinline__ void operator()(const f32x4 (&acc)[2][2][4][2], const Unit& u, int wr, int wc, int fr, int fq) const {
        const int row0 = u.pm * BM + wr * 64 + fr, col0 = u.pn * BM + wc * 32 + 4 * fq;
        const int ci = u.pm < 16 ? 0 : 1 + ((u.pm - 16) >> 3);
        const float* gp = mod + ci * 6144 + goff;
        f32x4 bv[2][2], gv[2][2];
#pragma unroll
        for (int bj = 0; bj < 2; ++bj)
#pragma unroll
            for (int n = 0; n < 2; ++n) { bv[bj][n] = bias ? *(const f32x4*)(bias + col0 + bj * HALF + n * 16) : (f32x4){0.f, 0.f, 0.f, 0.f}; gv[bj][n] = *(const f32x4*)(gp + col0 + bj * HALF + n * 16); }
#pragma unroll
        for (int ai = 0; ai < 2; ++ai)
#pragma unroll
            for (int m = 0; m < 4; ++m) { const int row = row0 + ai * HALF + m * 16;
                const float* xr = (row < 4096 ? xlo + (size_t)row * 1024 : xhi + (size_t)(row - 4096) * 1024) + col0; float* zr = Z + (size_t)row * 1024 + col0;
#pragma unroll
                for (int bj = 0; bj < 2; ++bj)
#pragma unroll
                    for (int n = 0; n < 2; ++n) { const f32x4 xv = *(const f32x4*)(xr + bj * HALF + n * 16);
                        *(f32x4*)(zr + bj * HALF + n * 16) = xv * alpha + gv[bj][n] * (acc[ai][bj][m][n] + bv[bj][n]); } }
    }
};
template <class Epi, class Sched, bool ALIGN_EPI = false, bool SP2 = false>
__device__ __forceinline__ void gemm_phase(PG8_LAS unsigned char* lds, const Gemm g, const Sched& S, const Epi& E) {
    int tid_ = threadIdx.x; asm volatile("" : "+v"(tid_));
    const int tid = tid_, wid = __builtin_amdgcn_readfirstlane(tid >> 6), lane = tid & 63, wr = wid >> 2, wc = wid & 3, fr = lane & 15, fq = lane >> 4;
    const int K = g.K, nt = K / BK;
    unsigned voffA[2], voffB[2];
#pragma unroll
    for (int i = 0; i < 2; ++i) { int R, C; stage_rc(tid * 16 + i * 8192, R, C); const int Rb = Epi::PERM ? ((R & ~31) + perm32(R & 31)) : R;
        voffA[i] = (unsigned)(R * K + C) * 2u; voffB[i] = (unsigned)(Rb * K + C) * 2u; }
    const size_t kstep = (size_t)(BK * 2);
    const size_t hstep = (size_t)HALF * K * 2;
    const size_t tstep = 2 * hstep;
    const unsigned ldsw = (unsigned)wid * 1024u;
    const int aoff = lds_byte(wr * 64 + fr, fq * 8), boff = lds_byte(wc * 32 + fr, fq * 8);
#define PG8_SA(b, h) (((b) * 2 + (h)) * HTB)
#define PG8_SB(b, h) ((4 + (b) * 2 + (h)) * HTB)
#define PG8_STAGE(bufoff, gbase, voff) do { _Pragma("unroll") for (int _i = 0; _i < 2; ++_i) \
        __builtin_amdgcn_global_load_lds((const unsigned*)((const char*)(gbase) + (voff)[_i]), (PG8_LAS unsigned*)(lds + (bufoff) + ldsw + _i * 8192), 16, 0, 0); } while (0)
#define PG8_LDA(dst, b, h) do { _Pragma("unroll") for (int m = 0; m < 4; ++m) _Pragma("unroll") for (int k = 0; k < 2; ++k) dst[m][k] = *(const PG8_LAS bf16x8*)(lds + PG8_SA(b, h) + aoff + m * 2048 + k * 1024); } while (0)
#define PG8_LDB(dst, b, h) do { _Pragma("unroll") for (int n = 0; n < 2; ++n) _Pragma("unroll") for (int k = 0; k < 2; ++k) dst[n][k] = *(const PG8_LAS bf16x8*)(lds + PG8_SB(b, h) + boff + n * 2048 + k * 1024); } while (0)
#define PG8_MMA(ai, bj, At, Bt) do { __builtin_amdgcn_s_setprio(1); _Pragma("unroll") for (int m = 0; m < 4; ++m) _Pragma("unroll") for (int n = 0; n < 2; ++n) _Pragma("unroll") for (int k = 0; k < 2; ++k) \
        acc[ai][bj][m][n] = __builtin_amdgcn_mfma_f32_16x16x32_bf16(Bt[n][k], At[m][k], acc[ai][bj][m][n], 0, 0, 0); __builtin_amdgcn_s_setprio(0); } while (0)
#define PG8_WAIT_V(n) asm volatile("s_waitcnt vmcnt(" #n ")" ::: "memory")
#define PG8_WAIT_L(n) asm volatile("s_waitcnt lgkmcnt(" #n ")" ::: "memory")
#define PG8_BAR __builtin_amdgcn_s_barrier()
#define PG8_SCHED __builtin_amdgcn_sched_barrier(0)
    Unit cur, nxt; int ui = 0;
    if (!S.next(0, cur)) return;
    f32x4 acc[2][2][4][2];
#pragma unroll
    for (int a = 0; a < 2; ++a)
#pragma unroll
        for (int b = 0; b < 2; ++b)
#pragma unroll
            for (int m = 0; m < 4; ++m)
#pragma unroll
                for (int n = 0; n < 2; ++n) acc[a][b][m][n] = (f32x4){0.f, 0.f, 0.f, 0.f};
    bf16x8 At[4][2], B0[2][2], B1[2][2];
    const char* cA = (const char*)g.A + (size_t)cur.pm * tstep; const char* cB = (const char*)g.Bt + (size_t)cur.pn * tstep;
    S.a_ready(cur);
    if constexpr (SP2) {
        PG8_STAGE(PG8_SB(0, 0), cB, voffB); PG8_STAGE(PG8_SB(0, 1), cB + hstep, voffB); PG8_STAGE(PG8_SA(0, 0), cA, voffA); PG8_STAGE(PG8_SA(0, 1), cA + hstep, voffA);
        if (wr == 1) PG8_BAR;
        PG8_WAIT_V(2); PG8_BAR;
        PG8_STAGE(PG8_SB(1, 0), cB + kstep, voffB); PG8_STAGE(PG8_SA(1, 0), cA + kstep, voffA); PG8_STAGE(PG8_SB(1, 1), cB + hstep + kstep, voffB);
        PG8_WAIT_V(6); PG8_BAR;
    } else {
        PG8_STAGE(PG8_SB(0, 0), cB, voffB); PG8_STAGE(PG8_SA(0, 0), cA, voffA); PG8_STAGE(PG8_SB(0, 1), cB + hstep, voffB); PG8_STAGE(PG8_SA(0, 1), cA + hstep, voffA);
        if (wr == 1) PG8_BAR;
        PG8_WAIT_V(4); PG8_BAR;
        PG8_STAGE(PG8_SB(1, 0), cB + kstep, voffB); PG8_STAGE(PG8_SA(1, 0), cA + kstep, voffA); PG8_STAGE(PG8_SB(1, 1), cB + hstep + kstep, voffB);
        PG8_WAIT_V(6); PG8_BAR;
    }
    for (;;) {
        const bool has_next = S.next(ui + 1, nxt);
        const char* nA = has_next ? (const char*)g.A + (size_t)nxt.pm * tstep : cA; const char* nB = has_next ? (const char*)g.Bt + (size_t)nxt.pn * tstep : cB;
        for (int t = 0; t < nt; t += 2) {
            const bool last = (t == nt - 2);
            const char* a1 = cA + (size_t)(t + 1) * kstep;
            const char* a2 = last ? nA : cA + (size_t)(t + 2) * kstep; const char* b2 = last ? nB : cB + (size_t)(t + 2) * kstep;
            const char* a3 = a2 + kstep; const char* b3 = b2 + kstep;
            if (last && has_next) S.a_ready(nxt);
            if constexpr (SP2) {
            PG8_LDB(B0, 0, 0); PG8_LDB(B1, 0, 1); PG8_SCHED; PG8_LDA(At, 0, 0); PG8_STAGE(PG8_SA(1, 1), a1 + hstep, voffA);
            PG8_WAIT_V(8); PG8_WAIT_L(0); PG8_BAR; PG8_MMA(0, 0, At, B0); PG8_MMA(0, 1, At, B1); PG8_BAR; PG8_SCHED;
            PG8_LDA(At, 0, 1); PG8_STAGE(PG8_SB(0, 0), b2, voffB); PG8_STAGE(PG8_SB(0, 1), b2 + hstep, voffB); PG8_STAGE(PG8_SA(0, 0), a2, voffA);
            PG8_WAIT_V(8); PG8_WAIT_L(0); PG8_BAR; PG8_MMA(1, 0, At, B0); PG8_MMA(1, 1, At, B1); PG8_BAR; PG8_SCHED;
            PG8_LDB(B0, 1, 0); PG8_LDB(B1, 1, 1); PG8_SCHED; PG8_LDA(At, 1, 0); PG8_STAGE(PG8_SA(0, 1), a2 + hstep, voffA);
            PG8_WAIT_V(8); PG8_WAIT_L(0); PG8_BAR; PG8_MMA(0, 0, At, B0); PG8_MMA(0, 1, At, B1); PG8_BAR; PG8_SCHED;
            PG8_LDA(At, 1, 1); PG8_STAGE(PG8_SB(1, 0), b3, voffB); PG8_STAGE(PG8_SB(1, 1), b3 + hstep, voffB); PG8_STAGE(PG8_SA(1, 0), a3, voffA);
            PG8_WAIT_V(8); PG8_WAIT_L(0); PG8_BAR; PG8_MMA(1, 0, At, B0); PG8_MMA(1, 1, At, B1); PG8_BAR; PG8_SCHED;
            } else {
            PG8_LDB(B0, 0, 0); PG8_SCHED; PG8_LDA(At, 0, 0); PG8_STAGE(PG8_SA(1, 1), a1 + hstep, voffA);
            PG8_WAIT_L(8); PG8_BAR; PG8_WAIT_L(0); PG8_MMA(0, 0, At, B0); PG8_BAR; PG8_SCHED;
            PG8_LDB(B1, 0, 1); PG8_STAGE(PG8_SB(0, 0), b2, voffB);
            PG8_BAR; PG8_WAIT_L(0); PG8_MMA(0, 1, At, B1); PG8_BAR;
            PG8_LDA(At, 0, 1); PG8_STAGE(PG8_SA(0, 0), a2, voffA);
            PG8_BAR; PG8_WAIT_L(0); PG8_MMA(1, 0, At, B0); PG8_BAR; PG8_SCHED;
            PG8_STAGE(PG8_SB(0, 1), b2 + hstep, voffB);
            PG8_WAIT_V(6); PG8_BAR; PG8_MMA(1, 1, At, B1); PG8_BAR;
            PG8_LDB(B0, 1, 0); PG8_SCHED; PG8_LDA(At, 1, 0); PG8_STAGE(PG8_SA(0, 1), a2 + hstep, voffA);
            PG8_WAIT_L(8); PG8_BAR; PG8_WAIT_L(0); PG8_MMA(0, 0, At, B0); PG8_BAR; PG8_SCHED;
            PG8_LDB(B1, 1, 1); PG8_STAGE(PG8_SB(1, 0), b3, voffB);
            PG8_BAR; PG8_WAIT_L(0); PG8_MMA(0, 1, At, B1); PG8_BAR;
            PG8_LDA(At, 1, 1); PG8_STAGE(PG8_SA(1, 0), a3, voffA);
            PG8_BAR; PG8_WAIT_L(0); PG8_MMA(1, 0, At, B0); PG8_BAR; PG8_SCHED;
            PG8_STAGE(PG8_SB(1, 1), b3 + hstep, voffB);
            PG8_WAIT_V(6); PG8_BAR; PG8_MMA(1, 1, At, B1); PG8_BAR;
            }
        }
        if constexpr (ALIGN_EPI) { if (wr == 0) PG8_BAR; }
        if constexpr (!Epi::AFTER_DRAIN) { E(acc, cur, wr, wc, fr, fq); S.done(cur); }
        if (!has_next) break;
#pragma unroll
        for (int a = 0; a < 2; ++a)
#pragma unroll
            for (int b = 0; b < 2; ++b)
#pragma unroll
                for (int m = 0; m < 4; ++m)
#pragma unroll
                    for (int n = 0; n < 2; ++n) acc[a][b][m][n] = (f32x4){0.f, 0.f, 0.f, 0.f};
        cur = nxt; cA = nA; cB = nB; ++ui;
        if constexpr (ALIGN_EPI) { if (wr == 1) PG8_BAR; }
    }
    PG8_WAIT_V(0);
    if constexpr (!ALIGN_EPI) { if (wr == 0) PG8_BAR; }
    PG8_BAR;
    if constexpr (Epi::AFTER_DRAIN) { E.fused(acc, cur, wr, wc, fr, fq, lds, wid, lane); S.done(cur); }
#undef PG8_SA
#undef PG8_SB
#undef PG8_STAGE
#undef PG8_LDA
#undef PG8_LDB
#undef PG8_MMA
#undef PG8_WAIT_V
#undef PG8_WAIT_L
#undef PG8_BAR
#undef PG8_SCHED
}
}
#ifndef PG8_SP2
#define PG8_SP2 true
#endif
#ifndef PG8_ALIGN
#define PG8_ALIGN true
#endif
constexpr int NWAVES = 8;
constexpr int D = 1024, NTOK = 12288, NCTX = 4096, INC = 2560, FF = 4096, SW = 512;
constexpr int N_RET_UNITS = 192;
constexpr int N_S5_ITEMS = 192;
constexpr float LN_EPS = 1e-5f;
constexpr float ALPHA = 1.18920711500272f;
constexpr float KSCALE = 0.08838834764831845f;
constexpr float LOG2E = 1.4426950408889634f;

constexpr size_t MiB = 1u << 20;
constexpr size_t WS_CTL = 0, CTL_ZERO_BYTES = 64 * 1024;
constexpr size_t WS_MOD = 1 * MiB;
constexpr size_t WS_ABAR = 2 * MiB, WS_AT = WS_ABAR + 64 * 1024, WS_BTAB = WS_ABAR + 128 * 1024, WS_CTAB = WS_ABAR + 512 * 1024;
constexpr size_t WS_WIN = 4 * MiB, WS_WGLU = 9 * MiB, WS_WOUT = 10 * MiB, WS_WFF1 = 12 * MiB, WS_WFF2 = 20 * MiB;
constexpr size_t WS_H = 28 * MiB;
constexpr size_t WS_X1 = 52 * MiB;
constexpr size_t WS_PROJ = 100 * MiB;
constexpr size_t WS_KV = 160 * MiB;
constexpr size_t WS_E = 176 * MiB;
constexpr size_t WS_MIX = 184 * MiB;
constexpr size_t WS_YG = 208 * MiB;
constexpr size_t WS_FFH = 100 * MiB;
constexpr size_t WS_TZY = 220 * MiB;
constexpr size_t WS_WE = 228 * MiB;
constexpr size_t WS_U = 232 * MiB;
constexpr size_t WS_END = 244 * MiB;
constexpr int CW_BAR = 4096;

constexpr int RING_BYTES = 131072, S5_LDS_BYTES = 2 * 128 * 528, LDSCTL_OFF = S5_LDS_BYTES, MISC_OFF = LDSCTL_OFF + 320, LDS_BYTES = 147456;
static_assert(S5_LDS_BYTES >= RING_BYTES && MISC_OFF + 128 <= LDS_BYTES, "LDS map");

#define GAS __attribute__((address_space(1)))
#define LAS __attribute__((address_space(3)))
typedef unsigned short bf16;
typedef unsigned v4u __attribute__((ext_vector_type(4)));
typedef float f32x4 __attribute__((ext_vector_type(4)));
typedef float f32x2 __attribute__((ext_vector_type(2)));
typedef short bf16x8 __attribute__((ext_vector_type(8)));
#define LDS_WAIT() asm volatile("s_waitcnt lgkmcnt(0)" ::: "memory")
typedef __bf16 bf16x2_t __attribute__((ext_vector_type(2)));
__device__ __forceinline__ unsigned pk2(float lo, float hi) { unsigned r; asm("v_cvt_pk_bf16_f32 %0, %1, %2" : "=v"(r) : "v"(lo), "v"(hi)); return r; }
__device__ __forceinline__ unsigned f2bf(float f) { return pk2(f, f) & 0xffffu; }
__device__ __forceinline__ unsigned pk2c(float lo, float hi) { const f32x2 v = {lo, hi}; const bf16x2_t b = __builtin_convertvector(v, bf16x2_t); return __builtin_bit_cast(unsigned, b); }
__device__ __forceinline__ float bf2f(unsigned short b) { return __uint_as_float((unsigned)b << 16); }
__device__ __forceinline__ float bflo(unsigned w) { return __uint_as_float(w << 16); }
__device__ __forceinline__ float bfhi(unsigned w) { return __uint_as_float(w & 0xffff0000u); }

#define XB_TMO      128
#define XB_XCNT(j)  (256  + 64 * (j))
#define XB_XSUB(j)  (1280 + 64 * (j))
#define XB_XGEN(j)  (2304 + 64 * (j))
#define XB_TOP      3328
#define XB_TOPGEN   3392
#define XCD_BAR_WORDS 3456
#define XB_SPIN_CAP (1u << 18)
__device__ __forceinline__ unsigned xb_ld(unsigned* p)              { return __hip_atomic_load(p, __ATOMIC_RELAXED, __HIP_MEMORY_SCOPE_AGENT); }
__device__ __forceinline__ unsigned xb_add(unsigned* p, unsigned v) { return __hip_atomic_fetch_add(p, v, __ATOMIC_RELAXED, __HIP_MEMORY_SCOPE_AGENT); }
__device__ __forceinline__ unsigned xb_xcc_id() { return (unsigned)__builtin_amdgcn_s_getreg((3 << 11) | 20) & 0xFu; }
#define XB_SPIN(cond, bar) do { unsigned _sp = 0; while (cond) { __builtin_amdgcn_s_sleep(1); \
    if ((++_sp & 255u) == 0u) { if (xb_ld(&(bar)[XB_TMO])) break; if (_sp > XB_SPIN_CAP) { atomicAdd(&(bar)[XB_TMO], 1u); break; } } } } while (0)
struct XcdBarrier { unsigned* bar; unsigned x; volatile LAS unsigned* st; };
__device__ __forceinline__ XcdBarrier xcd_barrier_post(unsigned* bar, volatile LAS unsigned* st) {
    XcdBarrier b; b.bar = bar; b.x = xb_xcc_id(); b.st = st;
    if (threadIdx.x == 0) (void)xb_add(&bar[XB_XCNT(b.x)], 1u);
    return b;
}
__device__ __forceinline__ void xcd_barrier_complete(unsigned* bar, unsigned x, unsigned& nloc, unsigned& nx) {
    const unsigned G = gridDim.x * gridDim.y * gridDim.z;
    unsigned sum, cnt, mine, sp = 0u;
    for (;;) {
        sum = 0u; cnt = 0u; mine = 0u;
#pragma unroll
        for (unsigned j = 0; j < 16; ++j) { const unsigned c = xb_ld(&bar[XB_XCNT(j)]); sum += c; cnt += (c > 0u) ? 1u : 0u; mine = (j == x) ? c : mine; }
        if (sum == G) break;
        __builtin_amdgcn_s_sleep(1);
        if ((++sp & 255u) == 0u) { if (xb_ld(&bar[XB_TMO])) break; if (sp > XB_SPIN_CAP) { atomicAdd(&bar[XB_TMO], 1u); break; } }
    }
    nloc = mine > 0u ? mine : 1u; nx = cnt > 0u ? cnt : 1u;
}
__device__ __forceinline__ void xcd_barrier(const XcdBarrier& b) {
    asm volatile("s_waitcnt vmcnt(0)" ::: "memory");
    __syncthreads();
    if (threadIdx.x == 0) {
        unsigned* bar = b.bar;
        __builtin_amdgcn_s_waitcnt(0);
        unsigned nloc = b.st[0], nx = b.st[1];
        if (nloc == 0u) { xcd_barrier_complete(bar, b.x, nloc, nx); b.st[0] = nloc; b.st[1] = nx; }
        const unsigned old = xb_add(&bar[XB_XSUB(b.x)], 1u);
        const unsigned gen = old / nloc;
        if (old + 1u == (gen + 1u) * nloc) {
            __builtin_amdgcn_fence(__ATOMIC_RELEASE, "agent");
            asm volatile("s_waitcnt vmcnt(0)" ::: "memory");
            const unsigned og = xb_add(&bar[XB_TOP], 1u);
            const unsigned tg = og / nx;
            if (og + 1u == (tg + 1u) * nx) xb_add(&bar[XB_TOPGEN], 1u);
            else XB_SPIN(xb_ld(&bar[XB_TOPGEN]) == tg, bar);
            __builtin_amdgcn_fence(__ATOMIC_ACQUIRE, "agent");
            xb_add(&bar[XB_XGEN(b.x)], 1u);
            asm volatile("s_waitcnt vmcnt(0)" ::: "memory");
        } else {
            XB_SPIN(xb_ld(&bar[XB_XGEN(b.x)]) == gen, bar);
            __builtin_amdgcn_fence(__ATOMIC_ACQUIRE, "agent");
            asm volatile("s_waitcnt vmcnt(0)" ::: "memory");
        }
    }
    __syncthreads();
}

__device__ __forceinline__ float wave_sum(float v) {
#pragma unroll
    for (int o = 1; o < 64; o <<= 1) v += __shfl_xor(v, o);
    return v;
}
__device__ __forceinline__ float sum16(float v) {
    v += __shfl_xor(v, 1); v += __shfl_xor(v, 2); v += __shfl_xor(v, 4); v += __shfl_xor(v, 8); return v;
}
__device__ __forceinline__ float siluf(float v) { return v / (1.f + __expf(-v)); }
__device__ __forceinline__ float gelu_tanh(float x) {
    const float z = 0.7978845608028654f * (x + 0.044715f * x * x * x);
    const float t = 1.f - 2.f / (__expf(2.f * z) + 1.f);
    return 0.5f * x * (1.f + t);
}
__device__ __forceinline__ float log2_sigmoid(float x) { return -log1pf(expf(-x)) * LOG2E; }
__device__ __forceinline__ bf16x8 zero8() { return (bf16x8){0, 0, 0, 0, 0, 0, 0, 0}; }

__device__ __forceinline__ void p0_transpose_item(const float* W, int K, int N, bf16* WT, LAS float* scr, int item, int lane, int s0, int s1, float s) {
    const int nblk = N / 32, kb = item / nblk, nb = item % nblk, k0 = 64 * kb, n0 = 32 * nb;
    const float mul = (n0 >= s0 && n0 < s1) ? s : 1.f;
#pragma unroll 8
    for (int i = 0; i < 32; ++i) { const int kk = 2 * i + (lane >> 5); scr[kk * 33 + (lane & 31)] = W[(size_t)(k0 + kk) * N + n0 + (lane & 31)] * mul; }
    LDS_WAIT(); asm volatile("" ::: "memory");
    const int c = lane & 7;
#pragma unroll
    for (int j = 0; j < 4; ++j) { const int n = (lane >> 3) + 8 * j; const LAS float* sp = scr + (8 * c) * 33 + n;
        v4u o; o.x = pk2(sp[0 * 33], sp[1 * 33]); o.y = pk2(sp[2 * 33], sp[3 * 33]); o.z = pk2(sp[4 * 33], sp[5 * 33]); o.w = pk2(sp[6 * 33], sp[7 * 33]);
        *(GAS v4u*)(WT + (size_t)(n0 + n) * K + k0 + 8 * c) = o; }
    LDS_WAIT(); asm volatile("" ::: "memory");
}
__device__ __forceinline__ void p0_mod_item(LAS unsigned char* lds, int item, int tid, const float* c_ctx, const float* c, const float* w_ada, const float* b_ada, float* mod) {
    LAS float* sc = (LAS float*)lds; LAS float* red = (LAS float*)(lds + 20480);
    for (int i = tid; i < 5 * 1024; i += 512) { const int ci = i >> 10, k = i & 1023; const float v = (ci == 0) ? c_ctx[k] : c[(ci - 1) * 1024 + k]; sc[i] = siluf(v); }
    __syncthreads();
    const int col = tid & 31, kg = tid >> 5, n0 = item * 32;
    float acc[5] = {0.f, 0.f, 0.f, 0.f, 0.f};
#pragma unroll 16
    for (int kk = 0; kk < 64; ++kk) { const int k = kg * 64 + kk; const float w = w_ada[(size_t)k * 6144 + n0 + col];
#pragma unroll
        for (int ci = 0; ci < 5; ++ci) acc[ci] += sc[ci * 1024 + k] * w; }
#pragma unroll
    for (int ci = 0; ci < 5; ++ci) red[(kg * 5 + ci) * 32 + col] = acc[ci];
    __syncthreads();
    if (tid < 160) { const int ci = tid >> 5, c2 = tid & 31; float s = b_ada[n0 + c2];
#pragma unroll
        for (int g = 0; g < 16; ++g) s += red[(g * 5 + ci) * 32 + c2];
        mod[ci * 6144 + n0 + c2] = s; }
    __syncthreads();
}
__device__ __forceinline__ void p0_s5tab_item(LAS unsigned char* lds, int g, int dir, int tid, const float* a_re, const float* a_im, const float* log_dt, const float* b_re, const float* b_im,
                                              const float* c_re, const float* c_im, const float* dskip, f32x2* a16, bf16* tzy, bf16* we) {
    LAS f32x2* Cc = (LAS f32x2*)lds;
    LAS f32x2* BB = (LAS f32x2*)(lds + 8192);
    LAS f32x2* PW = (LAS f32x2*)(lds + 24576);
    LAS float* KK = (LAS float*)(lds + 33280);
    LAS float* K0 = (LAS float*)(lds + 54016);
    LAS float* DS = (LAS float*)(lds + 55296);
    if (tid < 128) {
        const int od = tid >> 6, d = od ? 1 - dir : dir, p = tid & 63, idx = (d * 32 + g) * 64 + p;
        const double are = (double)a_re[idx], aim = (double)a_im[idx], dt = exp((double)log_dt[d * 32 + g]);
        const double x = are * dt, y = aim * dt, ex = exp(x), br = ex * cos(y), bi = ex * sin(y);
        if (od == 0) { double pr = 1.0, pi = 0.0;
            for (int l = 0; l <= 16; ++l) { PW[l * 64 + p] = (f32x2){(float)pr, (float)pi}; const double nr = pr * br - pi * bi, ni = pr * bi + pi * br; pr = nr; pi = ni; }
            a16[idx] = PW[16 * 64 + p]; }
        const double nr = br - 1.0, ni = bi, den = are * are + aim * aim;
        const float cr = (float)((nr * are + ni * aim) / den), cim = (float)((ni * are - nr * aim) / den);
        const float* pre = b_re + (g * 64 + p) * 16; const float* pim = b_im + (g * 64 + p) * 16;
#pragma unroll
        for (int c = 0; c < 16; ++c) { const float r = pre[c], i = pim[c]; BB[(od * 64 + p) * 16 + c] = (f32x2){cr * r - cim * i, cr * i + cim * r}; }
    }
    for (int i = tid; i < 1024; i += 512) Cc[i] = (f32x2){c_re[g * 1024 + i], c_im[g * 1024 + i]};
    if (tid >= 128 && tid < 144) DS[tid - 128] = dskip[g * 16 + tid - 128];
    __syncthreads();
    {
        const int l = tid >> 5, c = (tid >> 1) & 15, hf = tid & 1;
        float acc[8];
#pragma unroll
        for (int e = 0; e < 8; ++e) acc[e] = 0.f;
        for (int p = 0; p < 64; ++p) { const f32x2 cc = Cc[c * 64 + p], pw = PW[l * 64 + p];
            const float gr = cc.x * pw.x - cc.y * pw.y, gi = cc.x * pw.y + cc.y * pw.x;
#pragma unroll
            for (int e = 0; e < 8; ++e) { const f32x2 bb = BB[p * 16 + 8 * hf + e]; acc[e] += gr * bb.x - gi * bb.y; } }
#pragma unroll
        for (int e = 0; e < 8; ++e) KK[l * 324 + c * 20 + 8 * hf + e] = acc[e];
        if (l == 0) {
#pragma unroll
            for (int e = 0; e < 8; ++e) acc[e] = 0.f;
            for (int p = 0; p < 64; ++p) { const f32x2 cc = Cc[c * 64 + p];
#pragma unroll
                for (int e = 0; e < 8; ++e) { const f32x2 bb = BB[(64 + p) * 16 + 8 * hf + e]; acc[e] += cc.x * bb.x - cc.y * bb.y; } }
#pragma unroll
            for (int e = 0; e < 8; ++e) K0[c * 20 + 8 * hf + e] = acc[e];
        }
    }
    __syncthreads();
    bf16* tz = tzy + (size_t)g * 256 * 512; bf16* wo = we + (size_t)g * 256 * 256;
    for (int q = tid; q < 4096; q += 512) {
        const int m = q & 15, n = q >> 4, t = n >> 4, c = n & 15;
        const bool mine = dir ? (m > t) : (m <= t);
        if (mine) {
            const int l = dir ? m - t : t - m;
            f32x4 v[4];
#pragma unroll
            for (int e = 0; e < 4; ++e) v[e] = *(const LAS f32x4*)(KK + l * 324 + c * 20 + 4 * e);
            if (m == t) {
#pragma unroll
                for (int e = 0; e < 4; ++e) v[e] = v[e] + *(const LAS f32x4*)(K0 + c * 20 + 4 * e);
                const float dsk = DS[c];
#pragma unroll
                for (int e = 0; e < 4; ++e) { if (c == 4 * e) v[e].x += dsk; if (c == 4 * e + 1) v[e].y += dsk; if (c == 4 * e + 2) v[e].z += dsk; if (c == 4 * e + 3) v[e].w += dsk; } }
            v4u w0, w1; w0.x = pk2(v[0].x, v[0].y); w0.y = pk2(v[0].z, v[0].w); w0.z = pk2(v[1].x, v[1].y); w0.w = pk2(v[1].z, v[1].w);
            w1.x = pk2(v[2].x, v[2].y); w1.y = pk2(v[2].z, v[2].w); w1.z = pk2(v[3].x, v[3].y); w1.w = pk2(v[3].z, v[3].w);
            *(GAS v4u*)(tz + (size_t)n * 512 + 16 * m) = w0; *(GAS v4u*)(tz + (size_t)n * 512 + 16 * m + 8) = w1;
        }
    }
    for (int v = tid; v < 256 * 16; v += 512) {
        const int n = v >> 4, j0 = (v & 15) * 8, t = n >> 4, c = n & 15, im = j0 >> 6, p0 = j0 & 63, l = dir ? 16 - t : t + 1; float o[8];
#pragma unroll
        for (int e = 0; e < 8; ++e) { const f32x2 cc = Cc[c * 64 + p0 + e], pw = PW[l * 64 + p0 + e];
            o[e] = im ? -(cc.x * pw.y + cc.y * pw.x) : (cc.x * pw.x - cc.y * pw.y); }
        v4u w; w.x = pk2(o[0], o[1]); w.y = pk2(o[2], o[3]); w.z = pk2(o[4], o[5]); w.w = pk2(o[6], o[7]);
        *(GAS v4u*)(tz + (size_t)n * 512 + 256 + 128 * dir + j0) = w;
    }
    for (int v = tid; v < 128 * 32; v += 512) {
        const int nn = v >> 5, k0 = (v & 31) * 8, im = nn >> 6, p = nn & 63, m = k0 >> 4, c0 = k0 & 15, l = dir ? m : 15 - m; float o[8];
        const f32x2 pw = PW[l * 64 + p];
#pragma unroll
        for (int e = 0; e < 8; ++e) { const f32x2 bb = BB[p * 16 + c0 + e]; o[e] = im ? (pw.x * bb.y + pw.y * bb.x) : (pw.x * bb.x - pw.y * bb.y); }
        v4u w; w.x = pk2(o[0], o[1]); w.y = pk2(o[2], o[3]); w.z = pk2(o[4], o[5]); w.w = pk2(o[6], o[7]);
        *(GAS v4u*)(wo + (size_t)(128 * dir + nn) * 256 + k0) = w;
    }
    __syncthreads();
}

__device__ __forceinline__ void row_load(const float* xrow, int lane, f32x4 (&v)[4]) {
    const GAS f32x4* xr = (const GAS f32x4*)xrow + lane;
#pragma unroll
    for (int j = 0; j < 4; ++j) v[j] = xr[64 * j];
}
__device__ __forceinline__ void row_norm(f32x4 (&v)[4]) {
    float s = 0.f;
#pragma unroll
    for (int j = 0; j < 4; ++j) s += (v[j].x + v[j].y) + (v[j].z + v[j].w);
    const float mean = wave_sum(s) * (1.f / D); float s2 = 0.f;
#pragma unroll
    for (int j = 0; j < 4; ++j) { v[j] = v[j] - mean; s2 += (v[j].x * v[j].x + v[j].y * v[j].y) + (v[j].z * v[j].z + v[j].w * v[j].w); }
    const float rstd = 1.f / sqrtf(wave_sum(s2) * (1.f / D) + LN_EPS);
#pragma unroll
    for (int j = 0; j < 4; ++j) v[j] = v[j] * rstd;
}
__device__ __forceinline__ void row_mod_store(const f32x4 (&v)[4], const float* sh, const float* scl, bf16* orow, int lane) {
    GAS unsigned long long* o8 = (GAS unsigned long long*)orow + lane;
#pragma unroll
    for (int j = 0; j < 4; ++j) { const f32x4 a = *((const GAS f32x4*)sh + lane + 64 * j), b = *((const GAS f32x4*)scl + lane + 64 * j);
        const f32x4 r = v[j] * (b + 1.f) + a;
        o8[64 * j] = (unsigned long long)pk2(r.x, r.y) | ((unsigned long long)pk2(r.z, r.w) << 32); }
}
__device__ __forceinline__ int cond_of_row(int m) { return m < NCTX ? 0 : 1 + ((m - NCTX) >> 11); }

struct RetUnit { int b, h, sc, row0, lu; bool ctx; };
__device__ __forceinline__ RetUnit ret_unit(int u) {
    RetUnit r; r.ctx = u < 64;
    if (r.ctx) { r.b = u >> 2; r.h = u & 3; r.sc = 0; r.row0 = r.b * 256; r.lu = 0; }
    else { const int lu = u - 64; r.lu = lu; r.b = lu >> 5; r.h = (lu >> 3) & 3; r.sc = lu & 7; r.row0 = NCTX + r.b * 2048 + r.sc * 256; }
    return r;
}
#define MFMA16(a, b, c) __builtin_amdgcn_mfma_f32_16x16x32_bf16((a), (b), (c), 0, 0, 0)
typedef short s16x4 __attribute__((ext_vector_type(4)));
__device__ __forceinline__ bf16x8 tr_frag(const LAS bf16* T, int pitch, int k0, int c0, int fr) {
    const LAS bf16* p = T + (k0 + (fr >> 2)) * pitch + c0 + 4 * (fr & 3);
    const s16x4 lo = __builtin_amdgcn_ds_read_tr16_b64_v4i16((LAS s16x4*)p);
    const s16x4 hi = __builtin_amdgcn_ds_read_tr16_b64_v4i16((LAS s16x4*)(p + 4 * pitch));
    return (bf16x8){lo[0], lo[1], lo[2], lo[3], hi[0], hi[1], hi[2], hi[3]};
}

__device__ __forceinline__ void ret_states_unit(LAS unsigned char* lds, int u, int tid, const bf16* proj, const float* ret_decay, bf16* kvws, float* out_state) {
    const int lane = tid & 63, w = __builtin_amdgcn_readfirstlane(tid >> 6), fr = lane & 15, fq = lane >> 4;
    const RetUnit U = ret_unit(u);
    const float lgf = log2_sigmoid(ret_decay[U.h]), lgb = log2_sigmoid(ret_decay[4 + U.h]);
    LAS bf16* Vs = (LAS bf16*)lds; LAS bf16* Kfs = (LAS bf16*)(lds + 17408); LAS bf16* Kbs = (LAS bf16*)(lds + 34816);
    f32x4 acc[2][8];
#pragma unroll
    for (int a = 0; a < 2; ++a)
#pragma unroll
        for (int c = 0; c < 8; ++c) acc[a][c] = (f32x4){0.f, 0.f, 0.f, 0.f};
    const int dir = w >> 2, dkb = (w & 3) * 32;
    v4u kreg[2], vreg[2];
#define R1_LOAD(sl) do { _Pragma("unroll") for (int i = 0; i < 2; ++i) { const int idx = tid + 512 * i; \
        const bf16* rp = proj + (size_t)(U.row0 + 64 * (sl) + (idx >> 4)) * INC + U.h * 128 + (idx & 15) * 8; kreg[i] = *(const GAS v4u*)(rp + 512); vreg[i] = *(const GAS v4u*)(rp + 1024); } } while (0)
    R1_LOAD(0);
    for (int sl = 0; sl < 4; ++sl) {
        __syncthreads();
#pragma unroll
        for (int i = 0; i < 2; ++i) { const int idx = tid + 512 * i, tt = idx >> 4, ch = idx & 15, tl = 64 * sl + tt;
            const float wf = __builtin_amdgcn_exp2f((float)(255 - tl) * lgf), wb = __builtin_amdgcn_exp2f((float)tl * lgb);
            const unsigned kw[4] = {kreg[i].x, kreg[i].y, kreg[i].z, kreg[i].w};
            v4u kf4, kb4;
            kf4.x = pk2(bflo(kw[0]) * wf, bfhi(kw[0]) * wf); kf4.y = pk2(bflo(kw[1]) * wf, bfhi(kw[1]) * wf); kf4.z = pk2(bflo(kw[2]) * wf, bfhi(kw[2]) * wf); kf4.w = pk2(bflo(kw[3]) * wf, bfhi(kw[3]) * wf);
            kb4.x = pk2(bflo(kw[0]) * wb, bfhi(kw[0]) * wb); kb4.y = pk2(bflo(kw[1]) * wb, bfhi(kw[1]) * wb); kb4.z = pk2(bflo(kw[2]) * wb, bfhi(kw[2]) * wb); kb4.w = pk2(bflo(kw[3]) * wb, bfhi(kw[3]) * wb);
            *(LAS v4u*)(Vs + tt * 136 + ch * 8) = vreg[i]; *(LAS v4u*)(Kfs + tt * 136 + ch * 8) = kf4; *(LAS v4u*)(Kbs + tt * 136 + ch * 8) = kb4; }
        __syncthreads();
        if (sl < 3) R1_LOAD(sl + 1);
        const LAS bf16* Kd = dir ? Kbs : Kfs;
        bf16x8 af[2][2];
#pragma unroll
        for (int rb = 0; rb < 2; ++rb)
#pragma unroll
            for (int ks = 0; ks < 2; ++ks) af[rb][ks] = tr_frag(Kd, 136, 32 * ks + 8 * fq, dkb + 16 * rb, fr);
#pragma unroll
        for (int cb = 0; cb < 8; ++cb)
#pragma unroll
            for (int ks = 0; ks < 2; ++ks) { const bf16x8 bfr = tr_frag(Vs, 136, 32 * ks + 8 * fq, 16 * cb, fr);
#pragma unroll
                for (int rb = 0; rb < 2; ++rb) acc[rb][cb] = MFMA16(af[rb][ks], bfr, acc[rb][cb]); }
    }
#undef R1_LOAD
    if (U.ctx) { float* o = out_state + (size_t)((U.b * 2 + dir) * 4 + U.h) * 16384;
#pragma unroll
        for (int rb = 0; rb < 2; ++rb)
#pragma unroll
            for (int cb = 0; cb < 8; ++cb)
#pragma unroll
                for (int r = 0; r < 4; ++r) o[(dkb + 16 * rb + 4 * fq + r) * 128 + 16 * cb + fr] = acc[rb][cb][r]; }
    else { bf16* o = kvws + ((size_t)U.lu * 2 + dir) * 16384;
#pragma unroll
        for (int rb = 0; rb < 2; ++rb)
#pragma unroll
            for (int cb = 0; cb < 8; ++cb) { const unsigned long long pk = (unsigned long long)pk2c(acc[rb][cb][0], acc[rb][cb][1]) | ((unsigned long long)pk2c(acc[rb][cb][2], acc[rb][cb][3]) << 32);
                *(GAS unsigned long long*)(o + (16 * cb + fr) * 128 + dkb + 16 * rb + 4 * fq) = pk; } }
}

__device__ __forceinline__ bf16x8 scale8(bf16x8 q, float s) {
    const v4u u = __builtin_bit_cast(v4u, q); v4u r;
    r.x = pk2(bflo(u.x) * s, bfhi(u.x) * s); r.y = pk2(bflo(u.y) * s, bfhi(u.y) * s); r.z = pk2(bflo(u.z) * s, bfhi(u.z) * s); r.w = pk2(bflo(u.w) * s, bfhi(u.w) * s);
    return __builtin_bit_cast(bf16x8, r);
}
__device__ __forceinline__ void ret_out_unit(LAS unsigned char* lds, int u, int tid, const bf16* proj, const float* ret_decay, const bf16* kvws, const float* state_ret, bf16* mix) {
    const int lane = tid & 63, w = __builtin_amdgcn_readfirstlane(tid >> 6), fr = lane & 15, fq = lane >> 4;
    const RetUnit U = ret_unit(u);
    const float lgf = log2_sigmoid(ret_decay[U.h]), lgb = log2_sigmoid(ret_decay[4 + U.h]);
    LAS bf16* Ks = (LAS bf16*)lds;
    LAS bf16* Vs = (LAS bf16*)(lds + 17408);
    LAS bf16* Vt = (LAS bf16*)(lds + 34816);
    LAS bf16* Ps = (LAS bf16*)(lds + 53248 + w * 4608);
    bf16x8 qf[2][4];
#pragma unroll
    for (int rb = 0; rb < 2; ++rb)
#pragma unroll
        for (int ks = 0; ks < 4; ++ks) qf[rb][ks] = *(const GAS bf16x8*)(proj + (size_t)(U.row0 + 32 * w + 16 * rb + fr) * INC + U.h * 128 + 32 * ks + 8 * fq);
    f32x4 o[2][8];
#pragma unroll
    for (int a = 0; a < 2; ++a)
#pragma unroll
        for (int c = 0; c < 8; ++c) o[a][c] = (f32x4){0.f, 0.f, 0.f, 0.f};
    v4u kreg[2], vreg[2];
#define R2_LOAD(j) do { _Pragma("unroll") for (int i = 0; i < 2; ++i) { const int idx = tid + 512 * i; \
        kreg[i] = *(const GAS v4u*)(proj + (size_t)(U.row0 + 64 * (j) + (idx >> 4)) * INC + 512 + U.h * 128 + (idx & 15) * 8); \
        vreg[i] = *(const GAS v4u*)(proj + (size_t)(U.row0 + 64 * (j) + (idx >> 4)) * INC + 1024 + U.h * 128 + (idx & 15) * 8); } } while (0)
    R2_LOAD(0);
    for (int j = 0; j < 4; ++j) {
        __syncthreads();
#pragma unroll
        for (int i = 0; i < 2; ++i) { const int idx = tid + 512 * i;
            *(LAS v4u*)(Ks + (idx >> 4) * 136 + (idx & 15) * 8) = kreg[i];
            *(LAS v4u*)(Vs + (idx >> 4) * 136 + (idx & 15) * 8) = vreg[i]; }
        __syncthreads();
        if (j < 3) R2_LOAD(j + 1);
#pragma unroll
        for (int cb = 0; cb < 4; ++cb) {
            bf16x8 kf[4];
#pragma unroll
            for (int ks = 0; ks < 4; ++ks) kf[ks] = *(const LAS bf16x8*)(Ks + (16 * cb + fr) * 136 + 32 * ks + 8 * fq);
#pragma unroll
            for (int rb = 0; rb < 2; ++rb) { f32x4 sc4 = (f32x4){0.f, 0.f, 0.f, 0.f};
#pragma unroll
                for (int ks = 0; ks < 4; ++ks) sc4 = MFMA16(qf[rb][ks], kf[ks], sc4);
#pragma unroll
                for (int r = 0; r < 4; ++r) { const int d = (32 * w + 16 * rb + 4 * fq + r) - (64 * j + 16 * cb + fr);
                    const float dec = d > 0 ? __builtin_amdgcn_exp2f((float)d * lgf) : (d < 0 ? __builtin_amdgcn_exp2f((float)(-d) * lgb) : 2.f);
                    Ps[(16 * rb + 4 * fq + r) * 72 + 16 * cb + fr] = (bf16)f2bf(sc4[r] * dec); } } }
        LDS_WAIT();
        bf16x8 pf[2][2];
#pragma unroll
        for (int rb = 0; rb < 2; ++rb)
#pragma unroll
            for (int ks = 0; ks < 2; ++ks) pf[rb][ks] = *(const LAS bf16x8*)(Ps + (16 * rb + fr) * 72 + 32 * ks + 8 * fq);
#pragma unroll
        for (int cb = 0; cb < 8; ++cb)
#pragma unroll
            for (int ks = 0; ks < 2; ++ks) { const bf16x8 vf = tr_frag(Vs, 136, 32 * ks + 8 * fq, 16 * cb, fr);
#pragma unroll
                for (int rb = 0; rb < 2; ++rb) o[rb][cb] = MFMA16(pf[rb][ks], vf, o[rb][cb]); }
    }
#undef R2_LOAD
    if (!U.ctx) {
        for (int dir = 0; dir < 2; ++dir) {
            const float lg = dir ? lgb : lgf;
            float rs[2];
#pragma unroll
            for (int rb = 0; rb < 2; ++rb) { const int i = 32 * w + 16 * rb + fr; rs[rb] = __builtin_amdgcn_exp2f((float)(dir ? (256 - i) : (i + 1)) * lg); }
            for (int s2 = 0; s2 < 2; ++s2) {
                __syncthreads();
                { const int dv = tid >> 2, q4 = tid & 3;
                  const int lub = U.lu & ~7;
                  const float wgt0 = __builtin_amdgcn_exp2f(256.f * (float)(dir ? (7 - U.sc) : U.sc) * lg);
                  const float* s0p = state_ret + (size_t)((U.b * 2 + dir) * 4 + U.h) * 16384 + dv;
#pragma unroll
                  for (int hh = 0; hh < 2; ++hh) {
                      const int dk0 = 64 * s2 + 16 * q4 + 8 * hh;
                      float a[8];
#pragma unroll
                      for (int e = 0; e < 8; ++e) a[e] = wgt0 * s0p[(dk0 + e) * 128];
#pragma unroll
                      for (int s = 0; s < 8; ++s) { const bool use = dir ? (s > U.sc) : (s < U.sc);
                          const float wgt = use ? __builtin_amdgcn_exp2f(256.f * (float)(dir ? (s - U.sc - 1) : (U.sc - 1 - s)) * lg) : 0.f;
                          const v4u t0 = *(const GAS v4u*)(kvws + ((size_t)(lub + s) * 2 + dir) * 16384 + dv * 128 + dk0);
                          a[0] += wgt * bflo(t0.x); a[1] += wgt * bfhi(t0.x); a[2] += wgt * bflo(t0.y); a[3] += wgt * bfhi(t0.y);
                          a[4] += wgt * bflo(t0.z); a[5] += wgt * bfhi(t0.z); a[6] += wgt * bflo(t0.w); a[7] += wgt * bfhi(t0.w); }
                      v4u w0; w0.x = pk2(a[0], a[1]); w0.y = pk2(a[2], a[3]); w0.z = pk2(a[4], a[5]); w0.w = pk2(a[6], a[7]);
                      *(LAS v4u*)(Vt + dv * 72 + 16 * q4 + 8 * hh) = w0; } }
                __syncthreads();
                bf16x8 qs[2][2];
#pragma unroll
                for (int rb = 0; rb < 2; ++rb) { qs[rb][0] = scale8(s2 ? qf[rb][2] : qf[rb][0], rs[rb]); qs[rb][1] = scale8(s2 ? qf[rb][3] : qf[rb][1], rs[rb]); }
#pragma unroll
                for (int cb = 0; cb < 8; ++cb)
#pragma unroll
                    for (int ks = 0; ks < 2; ++ks) { const bf16x8 vf = *(const LAS bf16x8*)(Vt + (16 * cb + fr) * 72 + 32 * ks + 8 * fq);
#pragma unroll
                        for (int rb = 0; rb < 2; ++rb) o[rb][cb] = MFMA16(qs[rb][ks], vf, o[rb][cb]); }
            }
        }
    }
    int lane2 = lane; asm volatile("" : "+v"(lane2));
    const int fr2 = lane2 & 15, fq2 = lane2 >> 4;
#pragma unroll
    for (int rb = 0; rb < 2; ++rb)
#pragma unroll
        for (int r = 0; r < 4; ++r) {
            float sm = 0.f;
#pragma unroll
            for (int cb = 0; cb < 8; ++cb) sm += o[rb][cb][r];
            const float mean = sum16(sm) * (1.f / 128.f); float q = 0.f;
#pragma unroll
            for (int cb = 0; cb < 8; ++cb) { const float d = o[rb][cb][r] - mean; q += d * d; }
            const float rstd = 1.f / sqrtf(sum16(q) * (1.f / 128.f) + LN_EPS);
            const size_t tok = (size_t)(U.row0 + 32 * w + 16 * rb + 4 * fq2 + r);
            const bf16* gp = proj + tok * INC + 1536 + U.h * 128 + fr2; bf16* mp = mix + tok * D + U.h * 128 + fr2;
#pragma unroll
            for (int cb = 0; cb < 8; ++cb) { const float g = bf2f(gp[16 * cb]); mp[16 * cb] = (bf16)f2bf((o[rb][cb][r] - mean) * rstd * siluf(g)); }
        }
}

struct S5Ptrs { const bf16* proj; const f32x2* a16; const bf16* tzy; const bf16* we; const float* s0_re; const float* s0_im; bf16* yg; float* out_re; float* out_im; };
__device__ __forceinline__ void s5_item(LAS unsigned char* lds, int it, int tid, const S5Ptrs& P) {
    const int lane = tid & 63, w = __builtin_amdgcn_readfirstlane(tid >> 6), fr = lane & 15, fq = lane >> 4;
    const int g = it / 6, j6 = it - 6 * g;
    const bool ctx = j6 < 2;
    const int tokbase = ctx ? j6 * 2048 : NCTX + (j6 - 2) * 2048;
    LAS unsigned char* UL = lds;
    LAS unsigned char* EL = lds + 67584;
    {
        const bf16* up = P.proj + ((size_t)g * NTOK + tokbase) * 16;
        v4u t[8];
#pragma unroll
        for (int i = 0; i < 8; ++i) { const int pc = tid + 512 * i; t[i] = *(const GAS v4u*)(up + (size_t)pc * 8); }
#pragma unroll
        for (int i = 0; i < 8; ++i) { const int pc = tid + 512 * i, tok = pc >> 1, hf = pc & 1; *(LAS v4u*)(UL + (tok >> 4) * 528 + (tok & 15) * 32 + 16 * hf) = t[i]; }
    }
    __syncthreads();
#define S5_LDU(dst, rb) do { _Pragma("unroll") for (int ks = 0; ks < 8; ++ks) dst[ks] = *(const LAS bf16x8*)(UL + (16 * (rb) + fr) * 528 + (2 * ks + (fq >> 1)) * 32 + 16 * (fq & 1)); } while (0)
    {
        bf16x8 bE[2][8];
#pragma unroll
        for (int nb = 0; nb < 2; ++nb)
#pragma unroll
            for (int ks = 0; ks < 8; ++ks) bE[nb][ks] = *(const GAS bf16x8*)(P.we + ((size_t)g * 256 + 16 * (2 * w + nb) + fr) * 256 + 32 * ks + 8 * fq);
        for (int rb = 0; rb < 8; ++rb) {
            bf16x8 aU[8]; S5_LDU(aU, rb);
#pragma unroll
            for (int nb = 0; nb < 2; ++nb) { f32x4 acc = (f32x4){0.f, 0.f, 0.f, 0.f};
#pragma unroll
                for (int ks = 0; ks < 8; ++ks) acc = MFMA16(bE[nb][ks], aU[ks], acc);
                *(LAS unsigned long long*)(EL + (16 * rb + fr) * 528 + (16 * (2 * w + nb) + 4 * fq) * 2) = (unsigned long long)pk2c(acc[0], acc[1]) | ((unsigned long long)pk2c(acc[2], acc[3]) << 32); }
        }
    }
    __syncthreads();
    {
        const int nseq = ctx ? 8 : 1, cps = ctx ? 16 : 128;
        for (int q = w; q < 2 * nseq; q += NWAVES) {
            const int seq = q >> 1, dir = q & 1;
            const f32x2 A = P.a16[(dir * 32 + g) * 64 + lane];
            float sre = 0.f, sim = 0.f;
            if (!ctx) { const int si = (((j6 - 2) * 2 + dir) * 32 + g) * 64 + lane; sre = P.s0_re[si]; sim = P.s0_im[si]; }
            LAS bf16* base = (LAS bf16*)(EL + dir * 256) + lane;
            for (int i0 = 0; i0 < cps; i0 += 8) {
                float ere[8], eim[8];
#pragma unroll
                for (int i = 0; i < 8; ++i) { const int k = seq * cps + (dir ? cps - 1 - (i0 + i) : i0 + i); ere[i] = bf2f(base[k * 264]); eim[i] = bf2f(base[k * 264 + 64]); }
#pragma unroll
                for (int i = 0; i < 8; ++i) { const int k = seq * cps + (dir ? cps - 1 - (i0 + i) : i0 + i);
                    { const unsigned pk = pk2(sre, sim); base[k * 264] = (bf16)(pk & 0xffffu); base[k * 264 + 64] = (bf16)(pk >> 16); }
                    const float nr = A.x * sre - A.y * sim + ere[i], ni = A.x * sim + A.y * sre + eim[i]; sre = nr; sim = ni; }
            }
            if (ctx) { const int oi = (((j6 * 8 + seq) * 2 + dir) * 32 + g) * 64 + lane; P.out_re[oi] = sre; P.out_im[oi] = sim; }
        }
    }
    __syncthreads();
    {
        bf16x8 bT[2][16];
#pragma unroll
        for (int nb = 0; nb < 2; ++nb)
#pragma unroll
            for (int ks = 0; ks < 16; ++ks) bT[nb][ks] = *(const GAS bf16x8*)(P.tzy + ((size_t)g * 256 + 16 * (2 * w + nb) + fr) * 512 + 32 * ks + 8 * fq);
        for (int rb = 0; rb < 8; ++rb) {
            bf16x8 aU[8], aS[8]; S5_LDU(aU, rb);
#pragma unroll
            for (int ks = 0; ks < 8; ++ks) aS[ks] = *(const LAS bf16x8*)(EL + (16 * rb + fr) * 528 + (32 * ks + 8 * fq) * 2);
#pragma unroll
            for (int nb = 0; nb < 2; ++nb) { f32x4 acc = (f32x4){0.f, 0.f, 0.f, 0.f};
#pragma unroll
                for (int ks = 0; ks < 8; ++ks) acc = MFMA16(bT[nb][ks], aU[ks], acc);
#pragma unroll
                for (int ks = 0; ks < 8; ++ks) acc = MFMA16(bT[nb][8 + ks], aS[ks], acc);
                const size_t tok = (size_t)(tokbase + (16 * rb + fr) * 16 + 2 * w + nb);
                const unsigned long long pk = (unsigned long long)pk2(gelu_tanh(acc[0]), gelu_tanh(acc[1])) | ((unsigned long long)pk2(gelu_tanh(acc[2]), gelu_tanh(acc[3])) << 32);
                *(GAS unsigned long long*)(P.yg + tok * SW + g * 16 + 4 * fq) = pk; }
        }
    }
#undef S5_LDU
}

struct Args { const float* in[30]; float* out; unsigned char* ws; };
__global__ void __launch_bounds__(NWAVES * 64, 2) fwd_kernel(Args args) {
    extern __shared__ __attribute__((aligned(16))) unsigned char lds_raw[];
    LAS unsigned char* lds = (LAS unsigned char*)lds_raw;
    volatile LAS unsigned* MISC = (volatile LAS unsigned*)(lds + MISC_OFF);
    const int tid = threadIdx.x, lane = tid & 63, wave = __builtin_amdgcn_readfirstlane(tid >> 6);
    const int G = gridDim.x, bid = blockIdx.x;
    const int gw = bid * NWAVES + wave, NGW = G * NWAVES;
    unsigned char* ws = args.ws;
    for (int u = tid; u < (LDS_BYTES - LDSCTL_OFF) / 4; u += NWAVES * 64) ((LAS unsigned*)(lds + LDSCTL_OFF))[u] = 0u;
    __syncthreads();
    XcdBarrier bar = xcd_barrier_post((unsigned*)(ws + WS_CTL) + CW_BAR, MISC + 8);

    const float* x_prompt = args.in[0]; const float* x_sample = args.in[1]; const float* state_ret = args.in[2];
    const float* state_s5_re = args.in[3]; const float* state_s5_im = args.in[4]; const float* c_lat = args.in[5]; const float* c_ctx = args.in[6];
    const float* w_ada = args.in[7]; const float* b_ada = args.in[8]; const float* w_in = args.in[9]; const float* ret_decay = args.in[10];
    const float* s5_a_re = args.in[11]; const float* s5_a_im = args.in[12]; const float* s5_log_dt = args.in[13];
    const float* s5_b_re = args.in[14]; const float* s5_b_im = args.in[15]; const float* s5_c_re = args.in[16]; const float* s5_c_im = args.in[17];
    const float* s5_d = args.in[18]; const float* w_glu = args.in[19]; const float* b_glu = args.in[20]; const float* w_out = args.in[21];
    const float* ln1_g = args.in[22]; const float* ln1_b = args.in[23]; const float* w_ff1 = args.in[24]; const float* b_ff1 = args.in[25];
    const float* w_ff2 = args.in[26]; const float* b_ff2 = args.in[27]; const float* ln2_g = args.in[28]; const float* ln2_b = args.in[29];
    float* out = args.out;
    float* out_y = out;
    float* out_state = out + (size_t)NTOK * D;
    float* out_s5re = out_state + (size_t)16 * 2 * 4 * 128 * 128;
    float* out_s5im = out_s5re + 16 * 2 * 32 * 64;

    float* mod = (float*)(ws + WS_MOD);
    f32x2* a16tab = (f32x2*)(ws + WS_AT); bf16* TZY = (bf16*)(ws + WS_TZY); bf16* WE = (bf16*)(ws + WS_WE); bf16* UG = (bf16*)(ws + WS_U);
    bf16* WinT = (bf16*)(ws + WS_WIN); bf16* WgluT = (bf16*)(ws + WS_WGLU); bf16* WoutT = (bf16*)(ws + WS_WOUT); bf16* Wff1T = (bf16*)(ws + WS_WFF1); bf16* Wff2T = (bf16*)(ws + WS_WFF2);
    bf16* H = (bf16*)(ws + WS_H); float* X1 = (float*)(ws + WS_X1); bf16* PROJ = (bf16*)(ws + WS_PROJ); bf16* KV = (bf16*)(ws + WS_KV);
    bf16* MIX = (bf16*)(ws + WS_MIX); bf16* YG = (bf16*)(ws + WS_YG); bf16* FFH = (bf16*)(ws + WS_FFH);

    {
        if (bid < 192) p0_mod_item(lds, bid, tid, c_ctx, c_lat, w_ada, b_ada, mod);
        else p0_s5tab_item(lds, (bid - 192) >> 1, (bid - 192) & 1, tid, s5_a_re, s5_a_im, s5_log_dt, s5_b_re, s5_b_im, s5_c_re, s5_c_im, s5_d, a16tab, TZY, WE);
        __syncthreads();
        LAS float* scr = (LAS float*)(lds + wave * 16384);
        constexpr int I_IN = (D / 64) * (INC / 32), I_GLU = (SW / 64) * (SW / 32), I_OUT = (D / 64) * (D / 32), I_F1 = (D / 64) * (FF / 32), I_F2 = (FF / 64) * (D / 32);
        constexpr int NITEMS = I_IN + I_GLU + I_OUT + I_F1 + I_F2;
        if (bid < 192) for (int it = gw; it < NITEMS; it += 192 * NWAVES) {
            int r = it;
            if (r < I_IN) { p0_transpose_item(w_in, D, INC, WinT, scr, r, lane, 512, 1024, KSCALE); continue; } r -= I_IN;
            if (r < I_GLU) { p0_transpose_item(w_glu, SW, SW, WgluT, scr, r, lane, 0, 0, 1.f); continue; } r -= I_GLU;
            if (r < I_OUT) { p0_transpose_item(w_out, D, D, WoutT, scr, r, lane, 0, 0, 1.f); continue; } r -= I_OUT;
            if (r < I_F1) { p0_transpose_item(w_ff1, D, FF, Wff1T, scr, r, lane, 0, 0, 1.f); continue; } r -= I_F1;
            p0_transpose_item(w_ff2, FF, D, Wff2T, scr, r, lane, 0, 0, 1.f);
        }
    }
    xcd_barrier(bar);

    for (int m = gw; m < NTOK; m += NGW) {
        const float* xr = m < NCTX ? x_prompt + (size_t)m * D : x_sample + (size_t)(m - NCTX) * D;
        const float* mp = mod + cond_of_row(m) * 6144;
        f32x4 v[4]; row_load(xr, lane, v); row_norm(v); row_mod_store(v, mp, mp + 1024, H + (size_t)m * D, lane);
    }
    xcd_barrier(bar);

    {
        pg8::Gemm g{H, WinT, NTOK, INC, D}; pg8::StaticOrder S; S.init(NTOK, INC, G, bid);
        pg8::EpiProj Ep{PROJ, INC, UG, NTOK};
        pg8::gemm_phase<pg8::EpiProj, pg8::StaticOrder, PG8_ALIGN, PG8_SP2>(lds, g, S, Ep);
    }
    xcd_barrier(bar);

    S5Ptrs SP{UG, a16tab, TZY, WE, state_s5_re, state_s5_im, YG, out_s5re, out_s5im};
    { int tidp = tid; asm volatile("" : "+v"(tidp));
      if (bid < N_S5_ITEMS) s5_item(lds, bid, tidp, SP);
      else for (int i = 0; i < 3; ++i) ret_states_unit(lds, (bid - N_S5_ITEMS) * 3 + i, tidp, PROJ, ret_decay, KV, out_state); }
    xcd_barrier(bar);

    if (bid < N_RET_UNITS) { int tidp = tid; asm volatile("" : "+v"(tidp)); ret_out_unit(lds, bid, tidp, PROJ, ret_decay, KV, state_ret, MIX); }
    {
        pg8::Gemm g{YG, WgluT, NTOK, SW, SW}; pg8::StaticOrder S; S.init(NTOK, SW, G - N_RET_UNITS, bid < N_RET_UNITS ? (1 << 20) : bid - N_RET_UNITS);
        pg8::EpiGlu Ep{YG, SW, MIX, D, 512, b_glu};
        pg8::gemm_phase<pg8::EpiGlu, pg8::StaticOrder, PG8_ALIGN, PG8_SP2>(lds, g, S, Ep);
    }
    xcd_barrier(bar);

    {
        pg8::Gemm g{MIX, WoutT, NTOK, D, D}; pg8::StaticOrder S; S.init(NTOK, D, G, bid);
        pg8::EpiRes Ep{x_prompt, x_sample, out_y, nullptr, mod, 2048, ALPHA};
        pg8::gemm_phase<pg8::EpiRes, pg8::StaticOrder, PG8_ALIGN, PG8_SP2>(lds, g, S, Ep);
    }
    xcd_barrier(bar);

    for (int m = gw; m < NTOK; m += NGW) {
        const float* mp = mod + cond_of_row(m) * 6144;
        f32x4 v[4]; row_load(out_y + (size_t)m * D, lane, v); row_norm(v);
        GAS f32x4* xo = (GAS f32x4*)(X1 + (size_t)m * D) + lane;
#pragma unroll
        for (int j = 0; j < 4; ++j) { v[j] = v[j] * *((const GAS f32x4*)ln1_g + lane + 64 * j) + *((const GAS f32x4*)ln1_b + lane + 64 * j); xo[64 * j] = v[j]; }
        row_norm(v); row_mod_store(v, mp + 3072, mp + 4096, H + (size_t)m * D, lane);
    }
    xcd_barrier(bar);

    {
        pg8::Gemm g{H, Wff1T, NTOK, FF, D}; pg8::StaticOrder S; S.init(NTOK, FF, G, bid);
        pg8::EpiSqRelu Ep{FFH, FF, b_ff1};
        pg8::gemm_phase<pg8::EpiSqRelu, pg8::StaticOrder, PG8_ALIGN, PG8_SP2>(lds, g, S, Ep);
    }
    xcd_barrier(bar);

    {
        pg8::Gemm g{FFH, Wff2T, NTOK, D, FF}; pg8::StaticOrder S; S.init(NTOK, D, G, bid);
        pg8::EpiRes Ep{X1, X1 + (size_t)NCTX * D, out_y, b_ff2, mod, 5120, ALPHA};
        pg8::gemm_phase<pg8::EpiRes, pg8::StaticOrder, PG8_ALIGN, PG8_SP2>(lds, g, S, Ep);
    }
    xcd_barrier(bar);

    for (int m = gw; m < NTOK; m += NGW) {
        f32x4 v[4]; row_load(out_y + (size_t)m * D, lane, v); row_norm(v);
        GAS f32x4* yo = (GAS f32x4*)(out_y + (size_t)m * D) + lane;
#pragma unroll
        for (int j = 0; j < 4; ++j) yo[64 * j] = v[j] * *((const GAS f32x4*)ln2_g + lane + 64 * j) + *((const GAS f32x4*)ln2_b + lane + 64 * j);
    }
}

extern "C" void kernel_launch(void* const* d_in, const int* in_sizes, int n_in, void* d_out, int out_size, void* d_ws, size_t ws_size, hipStream_t stream) {
    static int grid = 0;
    if (grid == 0) {
        if (n_in != 30 || ws_size < WS_END) { fprintf(stderr, "kernel_launch: built for 30 inputs and >= %zu bytes of workspace; got n_in %d, ws %zu; nothing launched\n", (size_t)WS_END, n_in, ws_size); grid = -1; return; }
        int dev = 0, cus = 0, per_cu = 0;
        if (hipGetDevice(&dev) != hipSuccess || hipDeviceGetAttribute(&cus, hipDeviceAttributeMultiprocessorCount, dev) != hipSuccess) { fprintf(stderr, "kernel_launch: device query failed\n"); grid = -1; return; }
        if (hipFuncSetAttribute((const void*)fwd_kernel, hipFuncAttributeMaxDynamicSharedMemorySize, LDS_BYTES) != hipSuccess) { fprintf(stderr, "kernel_launch: hipFuncSetAttribute failed\n"); grid = -1; return; }
        if (hipOccupancyMaxActiveBlocksPerMultiprocessor(&per_cu, (const void*)fwd_kernel, NWAVES * 64, LDS_BYTES) != hipSuccess || per_cu < 1) {
            fprintf(stderr, "kernel_launch: occupancy query reports %d workgroups per CU; nothing launched\n", per_cu); (void)hipGetLastError(); grid = -1; return; }
        if (cus != 256) { fprintf(stderr, "kernel_launch: built for a 256-CU device (got %d); nothing launched\n", cus); grid = -1; return; }
        grid = cus;
    }
    if (grid < 0) return;
    (void)hipMemsetAsync((char*)d_ws + WS_CTL, 0, CTL_ZERO_BYTES, stream);
    Args a{};
    for (int i = 0; i < 30; ++i) a.in[i] = (const float*)d_in[i];
    a.out = (float*)d_out; a.ws = (unsigned char*)d_ws;
    hipLaunchKernelGGL(fwd_kernel, dim3(grid), dim3(NWAVES * 64), LDS_BYTES, stream, a);
}
```
